# Optimizing an MI355X kernel written in HIP

```python
import math
import jax, jax.numpy as jnp
from jax import lax
import numpy as np

D_MODEL = 2048
BATCH = 1
SEQ = 8192
DEPTH = 4
DEC_BATCH = 4
DEC_SEQ = 4096
PAST_LEN = 128

S5_WIDTH = D_MODEL // 2
S5_GROUP = 16
S5_GROUPS = S5_WIDTH // S5_GROUP
S5_STATE = 64
LRU_WIDTH = D_MODEL // 2
LRU_BLOCKS = 16
LRU_BLOCK = LRU_WIDTH // LRU_BLOCKS
LRU_C = 8.0
LRU_CONV = 4
LRU_CONV_LEFT = 2
FFN_HIDDEN = 3 * D_MODEL
FFN_CONV = 3
FFN_CONV_LEFT = 1
OFF_LRU_X = S5_WIDTH
OFF_LRU_G = S5_WIDTH + LRU_WIDTH
OFF_GATE_A = S5_WIDTH + 2 * LRU_WIDTH
OFF_GATE_B = OFF_GATE_A + D_MODEL
IN_COLS = OFF_GATE_B + D_MODEL
EPS = 1e-6
DT_MIN = 0.001
DT_MAX = 0.1

kernel_name = "hybrid_s5_rglru_bidir_encoder"


def _rmsnorm(x, g):
    xf = x.astype(jnp.float32)
    y = xf * lax.rsqrt(jnp.mean(xf * xf, axis=-1, keepdims=True) + EPS)
    return (y * g.astype(jnp.float32)).astype(x.dtype)


def _depthwise_conv(x, w, left):
    k = w.shape[0]
    s = x.shape[1]
    xp = jnp.pad(x, ((0, 0), (left, k - 1 - left), (0, 0)))
    y = xp[:, 0:s] * w[0]
    for j in range(1, k):
        y = y + xp[:, j:j + s] * w[j]
    return y


def _linear_scan_combine(e1, e2):
    a1, b1 = e1
    a2, b2 = e2
    return a1 * a2, a2 * b1 + b2


def _s5_direction(ug, a_re, a_im, log_dt, b_re, b_im, c_re, c_im, reverse):
    f32 = jnp.float32
    lam = lax.complex(a_re.astype(f32), a_im.astype(f32))
    dt = jnp.exp(log_dt.astype(f32))[:, None]
    a_bar = jnp.exp(lam * dt)
    b_bar = ((a_bar - 1.0) / lam)[:, :, None] * lax.complex(b_re.astype(f32), b_im.astype(f32))
    bu = jnp.einsum('bsgh,gph->bsgp', ug.astype(jnp.complex64), b_bar)
    a_all = jnp.broadcast_to(a_bar, bu.shape)
    _, h = lax.associative_scan(_linear_scan_combine, (a_all, bu), axis=1, reverse=reverse)
    c = lax.complex(c_re.astype(f32), c_im.astype(f32))
    return jnp.einsum('bsgp,ghp->bsgh', h, c).real


def _s5_branch(u, a_re, a_im, log_dt, b_re, b_im, c_re, c_im, d, w_glu):
    bsz, s, _ = u.shape
    uf = u.astype(jnp.float32)
    ug = uf.reshape(bsz, s, S5_GROUPS, S5_GROUP)
    y_f = _s5_direction(ug, a_re[0], a_im[0], log_dt[0], b_re[0], b_im[0], c_re[0], c_im[0], False)
    y_b = _s5_direction(ug, a_re[1], a_im[1], log_dt[1], b_re[1], b_im[1], c_re[1], c_im[1], True)
    y = (y_f + y_b).reshape(bsz, s, S5_WIDTH) + d.astype(jnp.float32) * uf
    y = jax.nn.gelu(y)
    y = y * jax.nn.sigmoid(y @ w_glu.astype(jnp.float32))
    return y.astype(u.dtype)


def _rglru_direction(xc, w_a, b_a, w_x, b_x, lam, reverse):
    f32 = jnp.float32
    bsz, s, _ = xc.shape
    xb = xc.reshape(bsz, s, LRU_BLOCKS, LRU_BLOCK)
    r = jax.nn.sigmoid(jnp.einsum('bshi,hij->bshj', xb, w_a.astype(f32)).reshape(bsz, s, LRU_WIDTH) + b_a.astype(f32))
    gi = jax.nn.sigmoid(jnp.einsum('bshi,hij->bshj', xb, w_x.astype(f32)).reshape(bsz, s, LRU_WIDTH) + b_x.astype(f32))
    log_a = -LRU_C * r * jax.nn.softplus(-lam.astype(f32))
    a = jnp.exp(log_a)
    b = jnp.sqrt(-jnp.expm1(2.0 * log_a)) * (gi * xc)
    _, h = lax.associative_scan(_linear_scan_combine, (a, b), axis=1, reverse=reverse)
    return h


def _rglru_branch(xr, gr, conv_w, conv_b, w_a, b_a, w_x, b_x, lam):
    xf = xr.astype(jnp.float32)
    xc = _depthwise_conv(xf, conv_w.astype(jnp.float32), LRU_CONV_LEFT) + conv_b.astype(jnp.float32)
    h = (_rglru_direction(xc, w_a[0], b_a[0], w_x[0], b_x[0], lam[0], False)
         + _rglru_direction(xc, w_a[1], b_a[1], w_x[1], b_x[1], lam[1], True))
    y = h * jax.nn.gelu(gr.astype(jnp.float32))
    return y.astype(xr.dtype)


def _mixer(xn, w_in, s5_a_re, s5_a_im, s5_log_dt, s5_b_re, s5_b_im, s5_c_re, s5_c_im, s5_d, s5_w_glu,
           lru_conv_w, lru_conv_b, lru_w_a, lru_b_a, lru_w_x, lru_b_x, lru_lambda,
           w_proj_a, w_proj_b, w_out):
    proj = xn @ w_in
    u = proj[..., :OFF_LRU_X]
    xr = proj[..., OFF_LRU_X:OFF_LRU_G]
    gr = proj[..., OFF_LRU_G:OFF_GATE_A]
    ga = proj[..., OFF_GATE_A:OFF_GATE_B]
    gb = proj[..., OFF_GATE_B:]
    ya = _s5_branch(u, s5_a_re, s5_a_im, s5_log_dt, s5_b_re, s5_b_im, s5_c_re, s5_c_im, s5_d, s5_w_glu)
    yb = _rglru_branch(xr, gr, lru_conv_w, lru_conv_b, lru_w_a, lru_b_a, lru_w_x, lru_b_x, lru_lambda)
    merged = jax.nn.sigmoid(ga) * (ya @ w_proj_a) + jax.nn.sigmoid(gb) * (yb @ w_proj_b)
    return merged @ w_out


def _conv_ffn(xn, w_up, conv_w, w_down):
    h = _depthwise_conv(xn @ w_up, conv_w, FFN_CONV_LEFT)
    gate = h[..., :FFN_HIDDEN]
    val = h[..., FFN_HIDDEN:]
    return (jax.nn.gelu(gate) * val) @ w_down


def _trunk(x, norm1_g, w_in, s5_a_re, s5_a_im, s5_log_dt, s5_b_re, s5_b_im, s5_c_re, s5_c_im, s5_d, s5_w_glu,
           lru_conv_w, lru_conv_b, lru_w_a, lru_b_a, lru_w_x, lru_b_x, lru_lambda,
           w_proj_a, w_proj_b, w_out, norm2_g, ffn_w_up, ffn_conv_w, ffn_w_down, final_g):
    for l in range(DEPTH):
        x = x + _mixer(_rmsnorm(x, norm1_g[l]), w_in[l], s5_a_re[l], s5_a_im[l], s5_log_dt[l],
                       s5_b_re[l], s5_b_im[l], s5_c_re[l], s5_c_im[l], s5_d[l], s5_w_glu[l],
                       lru_conv_w[l], lru_conv_b[l], lru_w_a[l], lru_b_a[l], lru_w_x[l], lru_b_x[l],
                       lru_lambda[l], w_proj_a[l], w_proj_b[l], w_out[l])
        x = x + _conv_ffn(_rmsnorm(x, norm2_g[l]), ffn_w_up[l], ffn_conv_w[l], ffn_w_down[l])
    return _rmsnorm(x, final_g)


def setup_inputs(seed: int = 0) -> dict:
    key = jax.random.key(seed)
    ks = jax.random.split(key, 32)
    f32 = jnp.float32
    L, D, G, P, H = DEPTH, D_MODEL, S5_GROUPS, S5_STATE, S5_GROUP
    W, NB, BLK, F = LRU_WIDTH, LRU_BLOCKS, LRU_BLOCK, FFN_HIDDEN

    def nrm(k, shape, scale):
        return jax.random.normal(k, shape, f32) * scale

    x_prompt = jax.random.normal(ks[0], (BATCH, SEQ, D), f32)
    x_sample = jax.random.normal(ks[1], (DEC_BATCH, DEC_SEQ, D), f32)
    norm1_g = 1.0 + nrm(ks[2], (L, D), 0.01)
    w_in = nrm(ks[3], (L, D, IN_COLS), D ** -0.5)
    n_idx = jnp.arange(P, dtype=f32)
    s5_a_re = -0.5 + nrm(ks[4], (L, 2, G, P), 0.01)
    s5_a_im = math.pi * n_idx + nrm(ks[5], (L, 2, G, P), 0.01)
    s5_log_dt = jax.random.uniform(ks[6], (L, 2, G), f32, math.log(DT_MIN), math.log(DT_MAX))
    s5_b_re = nrm(ks[7], (L, 2, G, P, H), (2.0 * H) ** -0.5)
    s5_b_im = nrm(ks[8], (L, 2, G, P, H), (2.0 * H) ** -0.5)
    s5_c_re = nrm(ks[9], (L, 2, G, H, P), (2.0 * P) ** -0.5)
    s5_c_im = nrm(ks[10], (L, 2, G, H, P), (2.0 * P) ** -0.5)
    s5_d = nrm(ks[11], (L, S5_WIDTH), 1.0)
    s5_w_glu = nrm(ks[12], (L, S5_WIDTH, S5_WIDTH), S5_WIDTH ** -0.5)
    lru_conv_w = nrm(ks[13], (L, LRU_CONV, W), LRU_CONV ** -0.5)
    lru_conv_b = nrm(ks[14], (L, W), 0.01)
    lru_w_a = nrm(ks[15], (L, 2, NB, BLK, BLK), BLK ** -0.5)
    lru_b_a = nrm(ks[16], (L, 2, W), 0.01)
    lru_w_x = nrm(ks[17], (L, 2, NB, BLK, BLK), BLK ** -0.5)
    lru_b_x = nrm(ks[18], (L, 2, W), 0.01)
    a_target = jax.random.uniform(ks[19], (L, 2, W), f32, 0.9, 0.999)
    s = a_target ** (1.0 / LRU_C)
    lru_lambda = jnp.log(s) - jnp.log1p(-s)
    w_proj_a = nrm(ks[20], (L, S5_WIDTH, D), S5_WIDTH ** -0.5)
    w_proj_b = nrm(ks[21], (L, W, D), W ** -0.5)
    w_out = nrm(ks[22], (L, D, D), D ** -0.5)
    norm2_g = 1.0 + nrm(ks[23], (L, D), 0.01)
    ffn_w_up = nrm(ks[24], (L, D, 2 * F), D ** -0.5)
    ffn_conv_w = nrm(ks[25], (L, FFN_CONV, 2 * F), FFN_CONV ** -0.5)
    ffn_w_down = nrm(ks[26], (L, F, D), F ** -0.5)
    final_g = 1.0 + nrm(ks[27], (D,), 0.01)
    return {"x_prompt": x_prompt, "x_sample": x_sample, "norm1_g": norm1_g, "w_in": w_in,
            "s5_a_re": s5_a_re, "s5_a_im": s5_a_im, "s5_log_dt": s5_log_dt,
            "s5_b_re": s5_b_re, "s5_b_im": s5_b_im, "s5_c_re": s5_c_re, "s5_c_im": s5_c_im,
            "s5_d": s5_d, "s5_w_glu": s5_w_glu, "lru_conv_w": lru_conv_w, "lru_conv_b": lru_conv_b,
            "lru_w_a": lru_w_a, "lru_b_a": lru_b_a, "lru_w_x": lru_w_x, "lru_b_x": lru_b_x,
            "lru_lambda": lru_lambda, "w_proj_a": w_proj_a, "w_proj_b": w_proj_b, "w_out": w_out,
            "norm2_g": norm2_g, "ffn_w_up": ffn_w_up, "ffn_conv_w": ffn_conv_w, "ffn_w_down": ffn_w_down,
            "final_g": final_g}


def reference(x_prompt, x_sample, norm1_g, w_in, s5_a_re, s5_a_im, s5_log_dt, s5_b_re, s5_b_im,
              s5_c_re, s5_c_im, s5_d, s5_w_glu, lru_conv_w, lru_conv_b, lru_w_a, lru_b_a, lru_w_x,
              lru_b_x, lru_lambda, w_proj_a, w_proj_b, w_out, norm2_g, ffn_w_up, ffn_conv_w,
              ffn_w_down, final_g):
    weights = (norm1_g, w_in, s5_a_re, s5_a_im, s5_log_dt, s5_b_re, s5_b_im, s5_c_re, s5_c_im, s5_d,
               s5_w_glu, lru_conv_w, lru_conv_b, lru_w_a, lru_b_a, lru_w_x, lru_b_x, lru_lambda,
               w_proj_a, w_proj_b, w_out, norm2_g, ffn_w_up, ffn_conv_w, ffn_w_down, final_g)
    y_prompt = _trunk(x_prompt, *weights)
    y_sample = _trunk(x_sample, *weights)
    return (y_prompt, y_sample)
```

```cpp
#include <hip/hip_runtime.h>
#include <cstdio>
#include <cstdint>

#ifndef MK_ONE_LAUNCH
#define MK_ONE_LAUNCH 0
#endif

#define LAS __attribute__((address_space(3)))
#define GAS __attribute__((address_space(1)))
typedef unsigned short bf16_t;
typedef short bf16x8 __attribute__((ext_vector_type(8)));
typedef float f32x4 __attribute__((ext_vector_type(4)));
typedef float f32x2 __attribute__((ext_vector_type(2)));
typedef unsigned u32x4 __attribute__((ext_vector_type(4)));
typedef unsigned u32x2 __attribute__((ext_vector_type(2)));

constexpr int D = 2048, T = 24576, DEPTH = 4, INC = 7168, FH = 6144, F2 = 12288;
constexpr int SG = 64, SP = 64, SH = 16, SL = 32;
constexpr int NCR = T / SL;
constexpr int UHW = SL * SH + 4 * SP;
constexpr int LT = 128, NTC = T / LT;
constexpr float EPS = 1e-6f;
constexpr int NPH_LAYER = 12, NPHASE = 2 + DEPTH * NPH_LAYER;

constexpr size_t MiB = 1u << 20;
constexpr size_t WS_CTL = 0, CTL_BYTES = 1 * MiB;
constexpr size_t WS_W = 2 * MiB;
constexpr size_t WL_IN = 0, WL_GLU = 28 * MiB, WL_PA = 30 * MiB, WL_PB = 34 * MiB, WL_OUT = 38 * MiB, WL_UP = 46 * MiB, WL_DOWN = 94 * MiB, WL_STRIDE = 118 * MiB;
constexpr size_t WS_S5 = WS_W + DEPTH * WL_STRIDE;
constexpr size_t S5_BT1 = 0, S5_BT2 = 16 * MiB, S5_STRIDE = 64 * MiB;
constexpr size_t WS_LRUW = WS_S5 + DEPTH * S5_STRIDE;
constexpr size_t LRUW_STRIDE = 512 * 1024;
constexpr size_t WS_XN = WS_LRUW + 2 * MiB;
constexpr size_t WS_R = WS_XN + 96 * MiB;
constexpr size_t R_UH = 0, R_XR = 72 * MiB, R_TMP = 0  , R_GG = 120 * MiB, R_SGA = 168 * MiB, R_SGB = 264 * MiB, R_SBUF = 360 * MiB, R_YA = 360 * MiB  ,
                 R_YG = 408 * MiB, R_YB = 456 * MiB, R_LSUM = 504 * MiB, R_CIN = 508 * MiB, R_MIX_END = 510 * MiB;
constexpr size_t R_ACT = 0, R_EDGE = 288 * MiB, R_FFN_END = 307 * MiB;
constexpr size_t WS_END = WS_R + R_MIX_END;
static_assert((size_t)SG * NCR * UHW * 2 == 72 * MiB && (size_t)T * 1024 * 2 == 48 * MiB && (size_t)SG * NCR * 256 * 4 == 48 * MiB, "sizes");
static_assert((size_t)96 * 4 * 2 * FH * 4 <= 19 * MiB && R_FFN_END <= R_MIX_END, "ffn overlay");

constexpr int CW_BAR = 4096;

constexpr int STAGE_BYTES = 131072, XCH_OFF = 131072, XCH_BYTES = 8192, MISC_OFF = XCH_OFF + XCH_BYTES, LDS_BYTES = 147456;

__device__ __forceinline__ unsigned cvt_pk_bf16(float lo, float hi) { unsigned r; asm volatile("v_cvt_pk_bf16_f32 %0, %1, %2" : "=v"(r) : "v"(lo), "v"(hi)); return r; }
__device__ __forceinline__ float bf_lo(unsigned w) { return __uint_as_float(w << 16); }
__device__ __forceinline__ float bf_hi(unsigned w) { return __uint_as_float(w & 0xffff0000u); }
__device__ __forceinline__ float fast_sigmoid(float x) { return __builtin_amdgcn_rcpf(1.0f + __expf(-x)); }
__device__ __forceinline__ float gelu_tanh(float x) { const float z = 1.5957691216f * (x + 0.044715f * x * x * x); return x * __builtin_amdgcn_rcpf(1.0f + __expf(-z)); }
__device__ __forceinline__ float wave_sum(float v) {
#pragma unroll
    for (int o = 1; o < 64; o <<= 1) v += __shfl_xor(v, o);
    return v;
}
__device__ __forceinline__ int opaque(int v) { asm volatile("" : "+v"(v)); return v; }
template <int CTRL> __device__ __forceinline__ float dppf(float x) { return __builtin_bit_cast(float, __builtin_amdgcn_update_dpp(0, __builtin_bit_cast(int, x), CTRL, 0xf, 0xf, false)); }

#define XB_TMO      128
#define XB_XCNT(j)  (256  + 64 * (j))
#define XB_XSUB(j)  (1280 + 64 * (j))
#define XB_XGEN(j)  (2304 + 64 * (j))
#define XB_TOP      3328
#define XB_TOPGEN   3392
#define XCD_BAR_WORDS 3456
#define XB_SPIN_CAP (1u << 22)
__device__ __forceinline__ unsigned xb_ld(unsigned* p)              { return __hip_atomic_load(p, __ATOMIC_RELAXED, __HIP_MEMORY_SCOPE_AGENT); }
__device__ __forceinline__ unsigned xb_add(unsigned* p, unsigned v) { return __hip_atomic_fetch_add(p, v, __ATOMIC_RELAXED, __HIP_MEMORY_SCOPE_AGENT); }
__device__ __forceinline__ unsigned xb_xcc_id() { return (unsigned)__builtin_amdgcn_s_getreg((3 << 11) | 20) & 0xFu; }
#define XB_SPIN(cond, bar) do { unsigned _sp = 0; while (cond) { __builtin_amdgcn_s_sleep(1); \
    if ((++_sp & 255u) == 0u) { if (xb_ld(&(bar)[XB_TMO])) break; if (_sp > XB_SPIN_CAP) { atomicAdd(&(bar)[XB_TMO], 1u); break; } } } } while (0)
struct XcdBarrier { unsigned* bar; unsigned x; volatile LAS unsigned* st; };
__device__ __forceinline__ XcdBarrier xcd_barrier_post(unsigned* bar, volatile LAS unsigned* st) {
    XcdBarrier b; b.bar = bar; b.x = xb_xcc_id(); b.st = st;
    if (threadIdx.x == 0) (void)xb_add(&bar[XB_XCNT(b.x)], 1u);
    return b;
}
__device__ __forceinline__ void xcd_barrier_complete(unsigned* bar, unsigned x, unsigned& nloc, unsigned& nx) {
    const unsigned G = gridDim.x * gridDim.y * gridDim.z;
    unsigned sum, cnt, mine, sp = 0u;
    for (;;) {
        sum = 0u; cnt = 0u; mine = 0u;
#pragma unroll
        for (unsigned j = 0; j < 16; ++j) { const unsigned c = xb_ld(&bar[XB_XCNT(j)]); sum += c; cnt += (c > 0u) ? 1u : 0u; mine = (j == x) ? c : mine; }
        if (sum == G) break;
        __builtin_amdgcn_s_sleep(1);
        if ((++sp & 255u) == 0u) { if (xb_ld(&bar[XB_TMO])) break; if (sp > XB_SPIN_CAP) { atomicAdd(&bar[XB_TMO], 1u); break; } }
    }
    nloc = mine > 0u ? mine : 1u; nx = cnt > 0u ? cnt : 1u;
}
__device__ __forceinline__ void xcd_barrier(const XcdBarrier& b) {
    asm volatile("s_waitcnt vmcnt(0)" ::: "memory");
    __syncthreads();
    if (threadIdx.x == 0) {
        unsigned* bar = b.bar;
        __builtin_amdgcn_s_waitcnt(0);
        unsigned nloc = b.st[0], nx = b.st[1];
        if (nloc == 0u) { xcd_barrier_complete(bar, b.x, nloc, nx); b.st[0] = nloc; b.st[1] = nx; }
        const unsigned old = xb_add(&bar[XB_XSUB(b.x)], 1u);
        const unsigned gen = old / nloc;
        if (old + 1u == (gen + 1u) * nloc) {
            __builtin_amdgcn_fence(__ATOMIC_RELEASE, "agent");
            asm volatile("s_waitcnt vmcnt(0)" ::: "memory");
            const unsigned og = xb_add(&bar[XB_TOP], 1u);
            const unsigned tg = og / nx;
            if (og + 1u == (tg + 1u) * nx) xb_add(&bar[XB_TOPGEN], 1u);
            else XB_SPIN(xb_ld(&bar[XB_TOPGEN]) == tg, bar);
            __builtin_amdgcn_fence(__ATOMIC_ACQUIRE, "agent");
            xb_add(&bar[XB_XGEN(b.x)], 1u);
            asm volatile("s_waitcnt vmcnt(0)" ::: "memory");
        } else {
            XB_SPIN(xb_ld(&bar[XB_XGEN(b.x)]) == gen, bar);
            __builtin_amdgcn_fence(__ATOMIC_ACQUIRE, "agent");
            asm volatile("s_waitcnt vmcnt(0)" ::: "memory");
        }
    }
    __syncthreads();
}

namespace pg8 {
constexpr int BM = 256, BK = 64, HALF = 128, HTB = HALF * BK * 2, NXCD = 8, WGM = 8;
__host__ __device__ __forceinline__ int lds_byte(int r, int c) { const int st = (r >> 4) * 2 + (c >> 5), rr = r & 15, cc = c & 31, ob = rr * 64 + cc * 2; return st * 1024 + (ob ^ (((ob >> 9) & 1) << 5)); }
__host__ __device__ __forceinline__ void stage_rc(int b, int& R, int& C) { const int st = b / 1024, sb = b % 1024, swz = sb ^ (((sb >> 9) & 1) << 5); R = (st >> 1) * 16 + swz / 64; C = (st & 1) * 32 + (swz % 64) / 2; }
__host__ __device__ __forceinline__ int perm32(int rho) { const int n = rho >> 4, i = rho & 15; return 8 * (i >> 2) + 4 * n + (i & 3); }

struct Unit { int arow, brow, pm, pn, g; };
struct Gemm { const bf16_t* A; const bf16_t* Bt; int lda, ldb, K; };

struct OrderMN {
    int nM, nN, nwg, G, c;
    __device__ void init(int M, int N, int G_, int c_) { nM = M / BM; nN = N / BM; nwg = nM * nN; G = G_; c = c_; }
    __device__ bool next(int i, Unit& u) const {
        const long L = (long)i * G + c; if (L >= nwg) return false;
        int wgid = (int)L; { const int q = nwg / NXCD, r = nwg % NXCD, xcd = wgid % NXCD, off = wgid / NXCD; wgid = (xcd < r ? xcd * (q + 1) : r * (q + 1) + (xcd - r) * q) + off; }
        const int nig = WGM * nN, gid = wgid / nig, fm = gid * WGM, gsz = (nM - fm) < WGM ? (nM - fm) : WGM;
        u.pm = fm + ((wgid % nig) % gsz); u.pn = (wgid % nig) / gsz; u.g = 0; u.arow = u.pm * BM; u.brow = u.pn * BM; return true;
    }
};
template <int NM, int NN, int AR, int BR, int NG> struct OrderBatched {
    int G, c;
    __device__ void init(int G_, int c_) { G = G_; c = c_; }
    __device__ bool next(int i, Unit& u) const {
        const int L = i * G + c; if (L >= NG * NM * NN) return false;
        const int g = L / (NM * NN), r = L % (NM * NN); u.g = g; u.pm = r % NM; u.pn = r / NM; u.arow = g * AR + u.pm * BM; u.brow = g * BR + u.pn * BM; return true;
    }
};

template <class Epi, class Sched>
__device__ __forceinline__ void gemm_phase(LAS unsigned char* lds, const Gemm g, const Sched& S, const Epi& E) {
    const int tid = opaque((int)threadIdx.x), wid = __builtin_amdgcn_readfirstlane(tid >> 6), lane = tid & 63, wr = wid >> 2, wc = wid & 3, fr = lane & 15, fq = lane >> 4;
    const int K = g.K, nt = K / BK;
    unsigned voffA[2], voffB[2];
#pragma unroll
    for (int i = 0; i < 2; ++i) { int R, C; stage_rc(tid * 16 + i * 8192, R, C); const int Rb = Epi::PERM ? ((R & ~31) + perm32(R & 31)) : R;
        voffA[i] = (unsigned)(R * g.lda + C) * 2u; voffB[i] = (unsigned)(Rb * g.ldb + C) * 2u; }
    const size_t kstep = (size_t)(BK * 2);
    const size_t hstepA = (size_t)HALF * g.lda * 2, hstepB = (size_t)HALF * g.ldb * 2;
    const size_t rstepA = (size_t)g.lda * 2, rstepB = (size_t)g.ldb * 2;
    const unsigned ldsw = (unsigned)wid * 1024u;
    const int aoff = lds_byte(wr * 64 + fr, fq * 8), boff = lds_byte(wc * 32 + fr, fq * 8);
#define PG8_SA(b, h) (((b) * 2 + (h)) * HTB)
#define PG8_SB(b, h) ((4 + (b) * 2 + (h)) * HTB)
#define PG8_STAGE(bufoff, gbase, voff) do { _Pragma("unroll") for (int _i = 0; _i < 2; ++_i) \
        __builtin_amdgcn_global_load_lds((const unsigned*)((const char*)(gbase) + (voff)[_i]), (LAS unsigned*)(lds + (bufoff) + ldsw + _i * 8192), 16, 0, 0); } while (0)
#define PG8_LDA(dst, b, h) do { _Pragma("unroll") for (int m = 0; m < 4; ++m) _Pragma("unroll") for (int k = 0; k < 2; ++k) dst[m][k] = *(const LAS bf16x8*)(lds + PG8_SA(b, h) + aoff + m * 2048 + k * 1024); } while (0)
#define PG8_LDB(dst, b, h) do { _Pragma("unroll") for (int n = 0; n < 2; ++n) _Pragma("unroll") for (int k = 0; k < 2; ++k) dst[n][k] = *(const LAS bf16x8*)(lds + PG8_SB(b, h) + boff + n * 2048 + k * 1024); } while (0)
#define PG8_MMA(ai, bj, At, Bt) do { __builtin_amdgcn_s_setprio(1); _Pragma("unroll") for (int m = 0; m < 4; ++m) _Pragma("unroll") for (int n = 0; n < 2; ++n) _Pragma("unroll") for (int k = 0; k < 2; ++k) \
        acc[ai][bj][m][n] = __builtin_amdgcn_mfma_f32_16x16x32_bf16(Bt[n][k], At[m][k], acc[ai][bj][m][n], 0, 0, 0); __builtin_amdgcn_s_setprio(0); } while (0)
#define PG8_WAIT_V(n) asm volatile("s_waitcnt vmcnt(" #n ")" ::: "memory")
#define PG8_WAIT_L(n) asm volatile("s_waitcnt lgkmcnt(" #n ")" ::: "memory")
#define PG8_BAR __builtin_amdgcn_s_barrier()
#define PG8_SCHED __builtin_amdgcn_sched_barrier(0)
    Unit cur, nxt; int ui = 0;
    if (!S.next(0, cur)) return;
    f32x4 acc[2][2][4][2];
#pragma unroll
    for (int a = 0; a < 2; ++a)
#pragma unroll
        for (int b = 0; b < 2; ++b)
#pragma unroll
            for (int m = 0; m < 4; ++m)
#pragma unroll
                for (int n = 0; n < 2; ++n) acc[a][b][m][n] = (f32x4){0.f, 0.f, 0.f, 0.f};
    bf16x8 At[4][2], B0[2][2], B1[2][2];
    const char* cA = (const char*)g.A + (size_t)cur.arow * rstepA; const char* cB = (const char*)g.Bt + (size_t)cur.brow * rstepB;
    PG8_STAGE(PG8_SB(0, 0), cB, voffB); PG8_STAGE(PG8_SB(0, 1), cB + hstepB, voffB); PG8_STAGE(PG8_SA(0, 0), cA, voffA); PG8_STAGE(PG8_SA(0, 1), cA + hstepA, voffA);
    if (wr == 1) PG8_BAR;
    PG8_WAIT_V(2); PG8_BAR;
    PG8_STAGE(PG8_SB(1, 0), cB + kstep, voffB); PG8_STAGE(PG8_SA(1, 0), cA + kstep, voffA); PG8_STAGE(PG8_SB(1, 1), cB + hstepB + kstep, voffB);
    PG8_WAIT_V(6); PG8_BAR;
    for (;;) {
        const bool has_next = S.next(ui + 1, nxt);
        const char* nA = has_next ? (const char*)g.A + (size_t)nxt.arow * rstepA : cA; const char* nB = has_next ? (const char*)g.Bt + (size_t)nxt.brow * rstepB : cB;
        for (int t = 0; t < nt; t += 2) {
            const bool last = (t == nt - 2);
            const char* a1 = cA + (size_t)(t + 1) * kstep;
            const char* a2 = last ? nA : cA + (size_t)(t + 2) * kstep; const char* b2 = last ? nB : cB + (size_t)(t + 2) * kstep;
            const char* a3 = a2 + kstep; const char* b3 = b2 + kstep;
            PG8_LDB(B0, 0, 0); PG8_LDB(B1, 0, 1); PG8_SCHED; PG8_LDA(At, 0, 0); PG8_STAGE(PG8_SA(1, 1), a1 + hstepA, voffA);
            PG8_WAIT_V(8); PG8_WAIT_L(0); PG8_BAR; PG8_MMA(0, 0, At, B0); PG8_MMA(0, 1, At, B1); PG8_BAR; PG8_SCHED;
            PG8_LDA(At, 0, 1); PG8_STAGE(PG8_SB(0, 0), b2, voffB); PG8_STAGE(PG8_SB(0, 1), b2 + hstepB, voffB); PG8_STAGE(PG8_SA(0, 0), a2, voffA);
            PG8_WAIT_V(8); PG8_WAIT_L(0); PG8_BAR; PG8_MMA(1, 0, At, B0); PG8_MMA(1, 1, At, B1); PG8_BAR; PG8_SCHED;
            PG8_LDB(B0, 1, 0); PG8_LDB(B1, 1, 1); PG8_SCHED; PG8_LDA(At, 1, 0); PG8_STAGE(PG8_SA(0, 1), a2 + hstepA, voffA);
            PG8_WAIT_V(8); PG8_WAIT_L(0); PG8_BAR; PG8_MMA(0, 0, At, B0); PG8_MMA(0, 1, At, B1); PG8_BAR; PG8_SCHED;
            PG8_LDA(At, 1, 1); PG8_STAGE(PG8_SB(1, 0), b3, voffB); PG8_STAGE(PG8_SB(1, 1), b3 + hstepB, voffB); PG8_STAGE(PG8_SA(1, 0), a3, voffA);
            PG8_WAIT_V(8); PG8_WAIT_L(0); PG8_BAR; PG8_MMA(1, 0, At, B0); PG8_MMA(1, 1, At, B1); PG8_BAR; PG8_SCHED;
        }
        if (wr == 0) PG8_BAR;
        E(acc, cur, wr, wc, fr, fq);
        if (!has_next) break;
#pragma unroll
        for (int a = 0; a < 2; ++a)
#pragma unroll
            for (int b = 0; b < 2; ++b)
#pragma unroll
                for (int m = 0; m < 4; ++m)
#pragma unroll
                    for (int n = 0; n < 2; ++n) acc[a][b][m][n] = (f32x4){0.f, 0.f, 0.f, 0.f};
        cur = nxt; cA = nA; cB = nB; ++ui;
        if (wr == 1) PG8_BAR;
    }
    PG8_WAIT_V(0);
    PG8_BAR;
#undef PG8_SA
#undef PG8_SB
#undef PG8_STAGE
#undef PG8_LDA
#undef PG8_LDB
#undef PG8_MMA
#undef PG8_WAIT_V
#undef PG8_WAIT_L
#undef PG8_BAR
#undef PG8_SCHED
}

typedef f32x4 Acc[2][2][4][2];
__device__ __forceinline__ u32x4 pack8(const f32x4 a, const f32x4 b) { u32x4 w; w.x = cvt_pk_bf16(a[0], a[1]); w.y = cvt_pk_bf16(a[2], a[3]); w.z = cvt_pk_bf16(b[0], b[1]); w.w = cvt_pk_bf16(b[2], b[3]); return w; }
__device__ __forceinline__ void unpack8(const u32x4 w, f32x4& a, f32x4& b) { a = (f32x4){bf_lo(w.x), bf_hi(w.x), bf_lo(w.y), bf_hi(w.y)}; b = (f32x4){bf_lo(w.z), bf_hi(w.z), bf_lo(w.w), bf_hi(w.w)}; }

struct EpiIn {
    static constexpr bool PERM = true;
    bf16_t *UH, *XR, *GG, *SGA, *SGB;
    __device__ __forceinline__ void operator()(const Acc& acc, const Unit& u, int wr, int wc, int fr, int fq) const {
        const int pn = u.pn, row0 = u.pm * BM + wr * 64 + fr, cb = pn * BM + wc * 32 + 8 * fq;
        int kind, ld = 1024, coff = 0; bf16_t* base = XR;
        if (pn < 4) kind = 0; else if (pn < 8) { kind = 1; base = XR; coff = cb - 1024; } else if (pn < 12) { kind = 2; base = GG; coff = cb - 2048; }
        else if (pn < 20) { kind = 3; base = SGA; ld = 2048; coff = cb - 3072; } else { kind = 3; base = SGB; ld = 2048; coff = cb - 5120; }
#pragma unroll
        for (int ai = 0; ai < 2; ++ai)
#pragma unroll
            for (int m = 0; m < 4; ++m) { const int r = row0 + ai * HALF + m * 16;
#pragma unroll
                for (int bj = 0; bj < 2; ++bj) { f32x4 v0 = acc[ai][bj][m][0], v1 = acc[ai][bj][m][1];
                    if (kind == 2) {
#pragma unroll
                        for (int j = 0; j < 4; ++j) { v0[j] = gelu_tanh(v0[j]); v1[j] = gelu_tanh(v1[j]); } }
                    else if (kind == 3) {
#pragma unroll
                        for (int j = 0; j < 4; ++j) { v0[j] = fast_sigmoid(v0[j]); v1[j] = fast_sigmoid(v1[j]); } }
                    const u32x4 w = pack8(v0, v1);
                    if (kind == 0) { const int c = cb + bj * HALF, gg = c >> 4; *(u32x4*)(UH + ((size_t)(gg * NCR + (r >> 5)) * UHW + (r & 31) * 16 + (c & 15))) = w; }
                    else *(u32x4*)(base + (size_t)r * ld + coff + bj * HALF) = w; } }
    }
};
struct EpiS1 {
    static constexpr bool PERM = false;
    float* C;
    __device__ __forceinline__ void operator()(const Acc& acc, const Unit& u, int wr, int wc, int fr, int fq) const {
        const int row0 = u.arow + wr * 64 + fr, col0 = wc * 32 + 4 * fq;
#pragma unroll
        for (int ai = 0; ai < 2; ++ai)
#pragma unroll
            for (int m = 0; m < 4; ++m) { float* rowp = C + (size_t)(row0 + ai * HALF + m * 16) * 256 + col0;
#pragma unroll
                for (int bj = 0; bj < 2; ++bj)
#pragma unroll
                    for (int n = 0; n < 2; ++n) *(f32x4*)(rowp + bj * HALF + n * 16) = acc[ai][bj][m][n]; }
    }
};
struct EpiS2 {
    static constexpr bool PERM = true;
    bf16_t* YG;
    __device__ __forceinline__ void operator()(const Acc& acc, const Unit& u, int wr, int wc, int fr, int fq) const {
        const int cr0 = u.pm * BM + wr * 64 + fr, nb = u.pn * BM + wc * 32 + 8 * fq;
#pragma unroll
        for (int ai = 0; ai < 2; ++ai)
#pragma unroll
            for (int m = 0; m < 4; ++m) { const int cr = cr0 + ai * HALF + m * 16;
#pragma unroll
                for (int bj = 0; bj < 2; ++bj) { f32x4 v0 = acc[ai][bj][m][0], v1 = acc[ai][bj][m][1];
#pragma unroll
                    for (int j = 0; j < 4; ++j) { v0[j] = gelu_tanh(v0[j]); v1[j] = gelu_tanh(v1[j]); }
                    const int n = nb + bj * HALF, t = n >> 4, i0 = n & 15;
                    *(u32x4*)(YG + (size_t)(cr * SL + t) * 1024 + u.g * 16 + i0) = pack8(v0, v1); } }
    }
};
template <int MODE> struct EpiMul {
    static constexpr bool PERM = true;
    bf16_t* O; const bf16_t* X1; int ld;
    __device__ __forceinline__ void operator()(const Acc& acc, const Unit& u, int wr, int wc, int fr, int fq) const {
        const int row0 = u.pm * BM + wr * 64 + fr, col0 = u.pn * BM + wc * 32 + 8 * fq;
#pragma unroll
        for (int ai = 0; ai < 2; ++ai)
#pragma unroll
            for (int m = 0; m < 4; ++m) { const size_t ro = (size_t)(row0 + ai * HALF + m * 16) * ld + col0;
#pragma unroll
                for (int bj = 0; bj < 2; ++bj) { f32x4 v0 = acc[ai][bj][m][0], v1 = acc[ai][bj][m][1], x0, x1;
                    unpack8(*(const u32x4*)(X1 + ro + bj * HALF), x0, x1);
                    if (MODE == 0) {
#pragma unroll
                        for (int j = 0; j < 4; ++j) { v0[j] = x0[j] * fast_sigmoid(v0[j]); v1[j] = x1[j] * fast_sigmoid(v1[j]); } }
                    else { v0 = v0 * x0; v1 = v1 * x1; }
                    if (MODE == 2) { f32x4 t0, t1; unpack8(*(const u32x4*)(O + ro + bj * HALF), t0, t1); v0 = v0 + t0; v1 = v1 + t1; }
                    *(u32x4*)(O + ro + bj * HALF) = pack8(v0, v1); } }
    }
};
struct EpiRes {
    static constexpr bool PERM = false;
    float* X;
    __device__ __forceinline__ void operator()(const Acc& acc, const Unit& u, int wr, int wc, int fr, int fq) const {
        const int row0 = u.pm * BM + wr * 64 + fr, col0 = u.pn * BM + wc * 32 + 4 * fq;
#pragma unroll
        for (int ai = 0; ai < 2; ++ai)
#pragma unroll
            for (int m = 0; m < 4; ++m) { float* rowp = X + (size_t)(row0 + ai * HALF + m * 16) * D + col0;
#pragma unroll
                for (int bj = 0; bj < 2; ++bj)
#pragma unroll
                    for (int n = 0; n < 2; ++n) { f32x4* p = (f32x4*)(rowp + bj * HALF + n * 16); *p = *p + acc[ai][bj][m][n]; } }
    }
};
struct EpiUp {
    static constexpr bool PERM = true;
    bf16_t* ACT; float* EDGE; const float* cw;
    LAS float* xch;
    __device__ __forceinline__ void operator()(const Acc& acc, const Unit& u, int wr, int wc, int fr, int fq) const {
        const int wid = wr * 4 + wc, pw = (1 - wr) * 4 + wc;
        const int gc0 = u.pn * HALF + wc * 32 + 8 * fq;
#pragma unroll
        for (int ai = 0; ai < 2; ++ai) {
            if (fr == 0) { LAS f32x4* p = (LAS f32x4*)(xch + (((wid * 2 + ai) * 2 + 0) * 4 + fq) * 16);
                p[0] = acc[ai][0][0][0]; p[1] = acc[ai][0][0][1]; p[2] = acc[ai][1][0][0]; p[3] = acc[ai][1][0][1]; }
            if (fr == 15) { LAS f32x4* p = (LAS f32x4*)(xch + (((wid * 2 + ai) * 2 + 1) * 4 + fq) * 16);
                p[0] = acc[ai][0][3][0]; p[1] = acc[ai][0][3][1]; p[2] = acc[ai][1][3][0]; p[3] = acc[ai][1][3][1]; }
        }
        {
            float* eb = EDGE + (size_t)u.pm * 4 * 2 * FH + gc0;
            if (wr == 0 && fr < 2) {
#pragma unroll
                for (int bj = 0; bj < 2; ++bj) { float* p = eb + (size_t)(fr * 2 + bj) * FH; *(f32x4*)p = acc[0][bj][0][0]; *(f32x4*)(p + 4) = acc[0][bj][0][1]; } }
            if (wr == 1 && fr >= 14) {
#pragma unroll
                for (int bj = 0; bj < 2; ++bj) { float* p = eb + (size_t)((fr - 12) * 2 + bj) * FH; *(f32x4*)p = acc[1][bj][3][0]; *(f32x4*)(p + 4) = acc[1][bj][3][1]; } }
        }
        asm volatile("s_waitcnt lgkmcnt(0)" ::: "memory"); __builtin_amdgcn_s_barrier(); asm volatile("" ::: "memory");
#pragma unroll
        for (int ai = 0; ai < 2; ++ai)
#pragma unroll
            for (int m = 0; m < 4; ++m) {
                const bool up_out = (wr == 0 && ai == 0), dn_out = (wr == 1 && ai == 1);
                const LAS f32x4* pu = (const LAS f32x4*)(xch + (((pw * 2 + ((wr == 0) ? 0 : ai)) * 2 + 1) * 4 + fq) * 16);
                const LAS f32x4* pd = (const LAS f32x4*)(xch + (((pw * 2 + ((wr == 0) ? ai : 1)) * 2 + 0) * 4 + fq) * 16);
                f32x4 o[2];
#pragma unroll
                for (int n = 0; n < 2; ++n) {
                    int zo = 0; asm volatile("" : "+s"(zo));
                    const float* cwp = cw + zo + gc0 + 4 * n;
                    f32x4 h[2];
#pragma unroll
                    for (int bj = 0; bj < 2; ++bj) {
                        const f32x4 w0 = *(const f32x4*)(cwp + bj * FH), w1 = *(const f32x4*)(cwp + F2 + bj * FH), w2 = *(const f32x4*)(cwp + 2 * F2 + bj * FH);
                        f32x4 upv, dnv;
                        if (m > 0) upv = acc[ai][bj][m > 0 ? m - 1 : 0][n]; else upv = up_out ? (f32x4){0.f, 0.f, 0.f, 0.f} : pu[bj * 2 + n];
                        if (m < 3) dnv = acc[ai][bj][m < 3 ? m + 1 : 3][n]; else dnv = dn_out ? (f32x4){0.f, 0.f, 0.f, 0.f} : pd[bj * 2 + n];
#pragma unroll
                        for (int j = 0; j < 4; ++j) {
                            const float cur = acc[ai][bj][m][n][j];
                            const float prev = dppf<0x121>(fr == 15 ? upv[j] : cur);
                            const float next = dppf<0x12F>(fr == 0 ? dnv[j] : cur);
                            h[bj][j] = w0[j] * prev + w1[j] * cur + w2[j] * next;
                        }
                    }
#pragma unroll
                    for (int j = 0; j < 4; ++j) o[n][j] = gelu_tanh(h[0][j]) * h[1][j];
                }
                const int r = u.pm * BM + ai * HALF + wr * 64 + m * 16 + fr;
                *(u32x4*)(ACT + (size_t)r * FH + gc0) = pack8(o[0], o[1]);
            }
    }
};
}

struct Args {
    const float* in[28]; float* out; unsigned char* ws; int ph_lo, ph_hi;
};
struct Ptrs {
    const Args* a;
    __device__ __forceinline__ const float* x_prompt() const { return a->in[0]; }
    __device__ __forceinline__ const float* x_sample() const { return a->in[1]; }
    __device__ __forceinline__ const float* norm1_g() const { return a->in[2]; }
    __device__ __forceinline__ const float* w_in() const { return a->in[3]; }
    __device__ __forceinline__ const float* s5_a_re() const { return a->in[4]; }
    __device__ __forceinline__ const float* s5_a_im() const { return a->in[5]; }
    __device__ __forceinline__ const float* s5_log_dt() const { return a->in[6]; }
    __device__ __forceinline__ const float* s5_b_re() const { return a->in[7]; }
    __device__ __forceinline__ const float* s5_b_im() const { return a->in[8]; }
    __device__ __forceinline__ const float* s5_c_re() const { return a->in[9]; }
    __device__ __forceinline__ const float* s5_c_im() const { return a->in[10]; }
    __device__ __forceinline__ const float* s5_d() const { return a->in[11]; }
    __device__ __forceinline__ const float* s5_w_glu() const { return a->in[12]; }
    __device__ __forceinline__ const float* lru_conv_w() const { return a->in[13]; }
    __device__ __forceinline__ const float* lru_conv_b() const { return a->in[14]; }
    __device__ __forceinline__ const float* lru_w_a() const { return a->in[15]; }
    __device__ __forceinline__ const float* lru_b_a() const { return a->in[16]; }
    __device__ __forceinline__ const float* lru_w_x() const { return a->in[17]; }
    __device__ __forceinline__ const float* lru_b_x() const { return a->in[18]; }
    __device__ __forceinline__ const float* lru_lambda() const { return a->in[19]; }
    __device__ __forceinline__ const float* w_proj_a() const { return a->in[20]; }
    __device__ __forceinline__ const float* w_proj_b() const { return a->in[21]; }
    __device__ __forceinline__ const float* w_out() const { return a->in[22]; }
    __device__ __forceinline__ const float* norm2_g() const { return a->in[23]; }
    __device__ __forceinline__ const float* ffn_w_up() const { return a->in[24]; }
    __device__ __forceinline__ const float* ffn_conv_w() const { return a->in[25]; }
    __device__ __forceinline__ const float* ffn_w_down() const { return a->in[26]; }
    __device__ __forceinline__ const float* final_g() const { return a->in[27]; }
};

__device__ __forceinline__ void transpose_item(const float* W, int K, int N, bf16_t* WT, int k0, int n0s, int n0d, float* scr, int lane) {
#pragma unroll 8
    for (int i = 0; i < 32; ++i) { const int kk = 2 * i + (lane >> 5); scr[kk * 33 + (lane & 31)] = W[(size_t)(k0 + kk) * N + n0s + (lane & 31)]; }
    asm volatile("s_waitcnt lgkmcnt(0)" ::: "memory");
    const int c = lane & 7;
#pragma unroll
    for (int j = 0; j < 4; ++j) { const int n = (lane >> 3) + 8 * j; const float* s = scr + (8 * c) * 33 + n;
        u32x4 o; o.x = cvt_pk_bf16(s[0 * 33], s[1 * 33]); o.y = cvt_pk_bf16(s[2 * 33], s[3 * 33]); o.z = cvt_pk_bf16(s[4 * 33], s[5 * 33]); o.w = cvt_pk_bf16(s[6 * 33], s[7 * 33]);
        *(u32x4*)(WT + (size_t)(n0d + n) * K + k0 + 8 * c) = o; }
    asm volatile("s_waitcnt lgkmcnt(0)" ::: "memory");
}
__device__ __forceinline__ void transpose_all(const float* W, int K, int N, unsigned char* ws, size_t woff, bool up_perm, float* scr, int lane, int gw, int ngw) {
    const int nblk = N / 32, per = (K / 64) * nblk, total = DEPTH * per;
    for (int it = gw; it < total; it += ngw) {
        const int l = it / per, r = it % per, kb = r / nblk, nb = r % nblk, n0d = nb * 32;
        int n0s = n0d;
        if (up_perm) { const int tile = n0d >> 8, wi = n0d & 255; n0s = (wi < 128) ? tile * 128 + wi : FH + tile * 128 + (wi - 128); }
        transpose_item(W + (size_t)l * K * N, K, N, (bf16_t*)(ws + WS_W + (size_t)l * WL_STRIDE + woff), kb * 64, n0s, n0d, scr, lane);
    }
}

__device__ __forceinline__ void s5_prep_item(const Ptrs& P, unsigned char* ws, int l, int g, float* lds, int tid) {
    float* Ktab = lds;
    float* apr = lds + 16384;
    float* api = apr + 2 * 33 * 64;
    float* bbr = api + 2 * 33 * 64;
    float* bbi = bbr + 2 * 64 * 16;
    for (int idx = tid; idx < 2 * 33 * 64; idx += 512) {
        const int d = idx / (33 * 64), r = idx % (33 * 64), tau = r / 64, p = r % 64;
        const size_t o = ((size_t)(l * 2 + d) * SG + g) * SP + p;
        const float dt = __expf(P.s5_log_dt()[(l * 2 + d) * SG + g]);
        const float x = P.s5_a_re()[o] * dt * (float)tau, y = P.s5_a_im()[o] * dt * (float)tau;
        const float e = expf(x); float sn, cs; sincosf(y, &sn, &cs);
        apr[idx] = e * cs; api[idx] = e * sn;
    }
    for (int idx = tid; idx < 2 * 64 * 16; idx += 512) {
        const int d = idx / 1024, p = (idx % 1024) / 16, j = idx % 16;
        const size_t o = ((size_t)(l * 2 + d) * SG + g) * SP + p;
        const float dt = expf(P.s5_log_dt()[(l * 2 + d) * SG + g]);
        const float lr = P.s5_a_re()[o], li = P.s5_a_im()[o], x = lr * dt, y = li * dt;
        float sn, cs; sincosf(y, &sn, &cs); float sh, ch; sincosf(0.5f * y, &sh, &ch);
        const float nr = expm1f(x) * cs - 2.0f * sh * sh, ni = expf(x) * sn;
        const float den = 1.0f / (lr * lr + li * li);
        const float qr = (nr * lr + ni * li) * den, qi = (ni * lr - nr * li) * den;
        const float br = P.s5_b_re()[o * 16 + j], bi = P.s5_b_im()[o * 16 + j];
        bbr[idx] = qr * br - qi * bi; bbi[idx] = qr * bi + qi * br;
    }
    __syncthreads();
    for (int idx = tid; idx < 2 * 32 * 256; idx += 512) {
        const int d = idx / 8192, tau = (idx % 8192) / 256, i = (idx % 256) / 16, j = idx % 16;
        const float* cr = P.s5_c_re() + (((size_t)(l * 2 + d) * SG + g) * SH + i) * SP; const float* ci = P.s5_c_im() + (((size_t)(l * 2 + d) * SG + g) * SH + i) * SP;
        float s = 0.f;
        for (int p = 0; p < 64; ++p) {
            const float ar = apr[(d * 33 + tau) * 64 + p], ai = api[(d * 33 + tau) * 64 + p], br = bbr[(d * 64 + p) * 16 + j], bi = bbi[(d * 64 + p) * 16 + j];
            const float wr_ = ar * br - ai * bi, wi_ = ar * bi + ai * br;
            s += cr[p] * wr_ - ci[p] * wi_;
        }
        Ktab[idx] = s;
    }
    __syncthreads();
    bf16_t* Bt2 = (bf16_t*)(ws + WS_S5 + (size_t)l * S5_STRIDE + S5_BT2) + (size_t)g * 512 * UHW;
    for (int pc = tid; pc < 512 * (UHW / 8); pc += 512) {
        const int n = pc / (UHW / 8), k8 = pc % (UHW / 8), t = n >> 4, i = n & 15;
        float v[8];
        if (k8 < 64) {
            const int s = k8 >> 1, j0 = (k8 & 1) * 8;
#pragma unroll
            for (int e = 0; e < 8; ++e) { const int j = j0 + e; float x;
                if (s < t) x = Ktab[(0 * 32 + (t - s)) * 256 + i * 16 + j];
                else if (s > t) x = Ktab[(1 * 32 + (s - t)) * 256 + i * 16 + j];
                else { x = Ktab[i * 16 + j] + Ktab[8192 + i * 16 + j]; if (i == j) x += P.s5_d()[(size_t)l * 1024 + g * 16 + i]; }
                v[e] = x; }
        } else {
            const int kk = (k8 - 64) * 8, sel = kk >> 6, p0 = kk & 63, d = sel >> 1, ex = d ? (32 - t) : (t + 1);
            const float* cr = P.s5_c_re() + (((size_t)(l * 2 + d) * SG + g) * SH + i) * SP; const float* ci = P.s5_c_im() + (((size_t)(l * 2 + d) * SG + g) * SH + i) * SP;
#pragma unroll
            for (int e = 0; e < 8; ++e) { const int p = p0 + e; const float ar = apr[(d * 33 + ex) * 64 + p], ai = api[(d * 33 + ex) * 64 + p];
                const float wr_ = cr[p] * ar - ci[p] * ai, wi_ = cr[p] * ai + ci[p] * ar;
                v[e] = (sel & 1) ? -wi_ : wr_; }
        }
        u32x4 o; o.x = cvt_pk_bf16(v[0], v[1]); o.y = cvt_pk_bf16(v[2], v[3]); o.z = cvt_pk_bf16(v[4], v[5]); o.w = cvt_pk_bf16(v[6], v[7]);
        *(u32x4*)(Bt2 + (size_t)n * UHW + k8 * 8) = o;
    }
    bf16_t* Bt1 = (bf16_t*)(ws + WS_S5 + (size_t)l * S5_STRIDE + S5_BT1) + (size_t)g * 256 * 512;
    for (int pc = tid; pc < 256 * 64; pc += 512) {
        const int n = pc / 64, k8 = pc % 64, sel = n >> 6, p = n & 63, d = sel >> 1, s = k8 >> 1, j0 = (k8 & 1) * 8, ex = d ? s : (31 - s);
        const float ar = apr[(d * 33 + ex) * 64 + p], ai = api[(d * 33 + ex) * 64 + p];
        float v[8];
#pragma unroll
        for (int e = 0; e < 8; ++e) { const float br = bbr[(d * 64 + p) * 16 + j0 + e], bi = bbi[(d * 64 + p) * 16 + j0 + e];
            v[e] = (sel & 1) ? (ar * bi + ai * br) : (ar * br - ai * bi); }
        u32x4 o; o.x = cvt_pk_bf16(v[0], v[1]); o.y = cvt_pk_bf16(v[2], v[3]); o.z = cvt_pk_bf16(v[4], v[5]); o.w = cvt_pk_bf16(v[6], v[7]);
        *(u32x4*)(Bt1 + (size_t)n * 512 + k8 * 8) = o;
    }
    __syncthreads();
}

__device__ __forceinline__ void lru_prep(const Ptrs& P, unsigned char* ws, int gt, int ngt) {
    const int total = DEPTH * 16 * 8 * 4 * 64;
    for (int idx = gt; idx < total; idx += ngt) {
        const int lane = idx & 63, f = (idx >> 6) & 3, w = (idx >> 8) & 7, hb = (idx >> 11) & 15, l = idx >> 15;
        const int d = w >> 2, cs = w & 3, mat = f >> 1, ks = f & 1;
        const float* W = (mat ? P.lru_w_x() : P.lru_w_a()) + ((size_t)((l * 2 + d) * 16 + hb) * 64) * 64;
        float v[8];
#pragma unroll
        for (int e = 0; e < 8; ++e) v[e] = W[(size_t)(32 * ks + 8 * (lane >> 4) + e) * 64 + 16 * cs + (lane & 15)];
        u32x4 o; o.x = cvt_pk_bf16(v[0], v[1]); o.y = cvt_pk_bf16(v[2], v[3]); o.z = cvt_pk_bf16(v[4], v[5]); o.w = cvt_pk_bf16(v[6], v[7]);
        *(u32x4*)(ws + WS_LRUW + (size_t)idx * 16) = o;
    }
}

template <int MODE> __device__ __forceinline__ void norm_phase(const Ptrs& P, float* X, bf16_t* XN, const float* gain, int gw, int ngw, int lane) {
    f32x4 gv[8];
#pragma unroll
    for (int j = 0; j < 8; ++j) gv[j] = *(const f32x4*)(gain + 4 * (lane + 64 * j));
    for (int m = gw; m < T; m += ngw) {
        const float* src = (MODE == 1) ? (m < 8192 ? P.x_prompt() + (size_t)m * D : P.x_sample() + (size_t)(m - 8192) * D) : X + (size_t)m * D;
        f32x4 v[8]; float s = 0.f;
#pragma unroll
        for (int j = 0; j < 8; ++j) { v[j] = *(const f32x4*)(src + 4 * (lane + 64 * j)); s += (v[j][0] * v[j][0] + v[j][1] * v[j][1]) + (v[j][2] * v[j][2] + v[j][3] * v[j][3]); }
        const float rstd = 1.0f / sqrtf(wave_sum(s) * (1.0f / D) + EPS);
#pragma unroll
        for (int j = 0; j < 8; ++j) {
            if (MODE == 1) *(f32x4*)(X + (size_t)m * D + 4 * (lane + 64 * j)) = v[j];
            const f32x4 y = v[j] * rstd * gv[j];
            if (MODE == 2) *(f32x4*)(X + (size_t)m * D + 4 * (lane + 64 * j)) = y;
            else { u32x2 o; o.x = cvt_pk_bf16(y[0], y[1]); o.y = cvt_pk_bf16(y[2], y[3]); *(u32x2*)(XN + (size_t)m * D + 4 * (lane + 64 * j)) = o; }
        }
    }
}

__device__ __forceinline__ bool seq_start(int m) { return m == 0 || (m >= 8192 && (m & 4095) == 0); }
__device__ __forceinline__ int seq_lo(int m) { return m < 8192 ? 0 : (m & ~4095); }
__device__ __forceinline__ int seq_hi(int m) { return m < 8192 ? 8192 : (m & ~4095) + 4096; }

constexpr int XC_LD = 68, XCB_LD = 72;
template <int PASS> __device__ __forceinline__ void lru_unit(const Ptrs& P, unsigned char* ws, int l, int tc, int hb, unsigned char* lds, int tid) {
    float* XC = (float*)lds;
    bf16_t* XCB = (bf16_t*)(lds + 128 * XC_LD * 4);
    float* HF = (float*)(lds + 128 * XC_LD * 4 + 128 * XCB_LD * 2);
    float* HB = HF + 128 * XC_LD;
    const bf16_t* XR = (const bf16_t*)(ws + WS_R + R_XR);
    const int t0 = tc * LT, ch0 = hb * 64, lo = seq_lo(t0), hi = seq_hi(t0);
    const int lane = tid & 63, wid = tid >> 6;
    {
        const float* cwp = P.lru_conv_w() + (size_t)l * 4 * 1024; const float* cbp = P.lru_conv_b() + (size_t)l * 1024;
#pragma unroll
        for (int it = 0; it < 2; ++it) {
            const int pc = tid + it * 512, r = pc >> 3, c8 = (pc & 7) * 8, tok = t0 + r, ch = ch0 + c8;
            float a[8];
#pragma unroll
            for (int e = 0; e < 8; ++e) a[e] = cbp[ch + e];
#pragma unroll
            for (int k = 0; k < 4; ++k) { const int ts = tok + k - 2;
                if (ts >= lo && ts < hi) { const u32x4 xv = *(const u32x4*)(XR + (size_t)ts * 1024 + ch); f32x4 x0, x1; pg8::unpack8(xv, x0, x1);
                    const f32x4 w0 = *(const f32x4*)(cwp + k * 1024 + ch), w1 = *(const f32x4*)(cwp + k * 1024 + ch + 4);
#pragma unroll
                    for (int e = 0; e < 4; ++e) { a[e] += w0[e] * x0[e]; a[4 + e] += w1[e] * x1[e]; } } }
#pragma unroll
            for (int e = 0; e < 8; ++e) XC[r * XC_LD + c8 + e] = a[e];
            u32x4 o; o.x = cvt_pk_bf16(a[0], a[1]); o.y = cvt_pk_bf16(a[2], a[3]); o.z = cvt_pk_bf16(a[4], a[5]); o.w = cvt_pk_bf16(a[6], a[7]);
            *(u32x4*)(XCB + r * XCB_LD + c8) = o;
        }
    }
    __syncthreads();
    const int d = wid >> 2, cs = wid & 3, q = lane >> 4, chl = cs * 16 + (lane & 15), ch = ch0 + chl;
    f32x4 accr[8], accg[8];
    {
        const bf16x8* wf = (const bf16x8*)(ws + WS_LRUW + ((size_t)((l * 16 + hb) * 8 + wid) * 4) * 1024) + lane;
        const bf16x8 ba0 = wf[0], ba1 = wf[64], bx0 = wf[128], bx1 = wf[192];
#pragma unroll
        for (int mt = 0; mt < 8; ++mt) {
            const bf16x8 a0 = *(const bf16x8*)(XCB + (mt * 16 + (lane & 15)) * XCB_LD + 8 * q), a1 = *(const bf16x8*)(XCB + (mt * 16 + (lane & 15)) * XCB_LD + 32 + 8 * q);
            f32x4 z = (f32x4){0.f, 0.f, 0.f, 0.f};
            accr[mt] = __builtin_amdgcn_mfma_f32_16x16x32_bf16(a0, ba0, z, 0, 0, 0); accr[mt] = __builtin_amdgcn_mfma_f32_16x16x32_bf16(a1, ba1, accr[mt], 0, 0, 0);
            accg[mt] = __builtin_amdgcn_mfma_f32_16x16x32_bf16(a0, bx0, z, 0, 0, 0); accg[mt] = __builtin_amdgcn_mfma_f32_16x16x32_bf16(a1, bx1, accg[mt], 0, 0, 0);
        }
    }
    const float b_a = P.lru_b_a()[(size_t)(l * 2 + d) * 1024 + ch], b_x = P.lru_b_x()[(size_t)(l * 2 + d) * 1024 + ch], lam = P.lru_lambda()[(size_t)(l * 2 + d) * 1024 + ch];
    const float c8v = -8.0f * (lam > 15.f ? expf(-lam) : log1pf(expf(-lam)));
#pragma unroll
    for (int mt = 0; mt < 8; ++mt)
#pragma unroll
        for (int rg = 0; rg < 4; ++rg) {
            const float xcv = XC[(mt * 16 + 4 * q + rg) * XC_LD + chl];
            const float r = fast_sigmoid(accr[mt][rg] + b_a), gi = fast_sigmoid(accg[mt][rg] + b_x);
            const float la = c8v * r, a = __expf(la), bm = sqrtf(-expm1f(2.0f * la));
            accr[mt][rg] = a; accg[mt][rg] = bm * gi * xcv;
        }
    const int qq = d ? 3 - q : q;
    const int src1 = d ? lane + 16 : lane - 16, src2 = d ? lane + 32 : lane - 32, srcl = d ? (lane & 15) : (lane & 15) + 48;
    float Ai[8], Bi[8], Ae[8], Be[8];
#pragma unroll
    for (int mt = 0; mt < 8; ++mt) {
        float A, B;
        if (d == 0) { A = accr[mt][0]; B = accg[mt][0];
#pragma unroll
            for (int rg = 1; rg < 4; ++rg) { B = B * accr[mt][rg] + accg[mt][rg]; A *= accr[mt][rg]; } }
        else { A = accr[mt][3]; B = accg[mt][3];
#pragma unroll
            for (int rg = 2; rg >= 0; --rg) { B = B * accr[mt][rg] + accg[mt][rg]; A *= accr[mt][rg]; } }
        float Ap = __shfl(A, src1), Bp = __shfl(B, src1);
        if (qq >= 1) { B = Bp * A + B; A = Ap * A; }
        Ap = __shfl(A, src2); Bp = __shfl(B, src2);
        if (qq >= 2) { B = Bp * A + B; A = Ap * A; }
        Ai[mt] = A; Bi[mt] = B;
        Ap = __shfl(A, src1); Bp = __shfl(B, src1);
        Ae[mt] = qq >= 1 ? Ap : 1.0f; Be[mt] = qq >= 1 ? Bp : 0.0f;
    }
    if (PASS == 1) {
        float A = 1.0f, B = 0.0f;
#pragma unroll
        for (int s = 0; s < 8; ++s) { const int mt = d ? 7 - s : s; const float At = __shfl(Ai[mt], srcl), Bt = __shfl(Bi[mt], srcl); B = B * At + Bt; A *= At; }
        if (q == 0) { float* o = (float*)(ws + WS_R + R_LSUM) + ((size_t)(d * NTC + tc) * 1024 + ch) * 2; o[0] = A; o[1] = B; }
    } else {
        float carry = ((const float*)(ws + WS_R + R_CIN))[(size_t)(d * NTC + tc) * 1024 + ch];
        float* Hout = d ? HB : HF;
#pragma unroll
        for (int s = 0; s < 8; ++s) { const int mt = d ? 7 - s : s;
            const float At = __shfl(Ai[mt], srcl), Bt = __shfl(Bi[mt], srcl);
            float h = Ae[mt] * carry + Be[mt];
            if (d == 0) {
#pragma unroll
                for (int rg = 0; rg < 4; ++rg) { h = accr[mt][rg] * h + accg[mt][rg]; Hout[(mt * 16 + 4 * q + rg) * XC_LD + chl] = h; } }
            else {
#pragma unroll
                for (int rg = 3; rg >= 0; --rg) { h = accr[mt][rg] * h + accg[mt][rg]; Hout[(mt * 16 + 4 * q + rg) * XC_LD + chl] = h; } }
            carry = At * carry + Bt;
        }
        __syncthreads();
        const bf16_t* GG = (const bf16_t*)(ws + WS_R + R_GG); bf16_t* YB = (bf16_t*)(ws + WS_R + R_YB);
#pragma unroll
        for (int it = 0; it < 2; ++it) {
            const int pc = tid + it * 512, r = pc >> 3, c8 = (pc & 7) * 8; const size_t go = (size_t)(t0 + r) * 1024 + ch0 + c8;
            f32x4 g0, g1; pg8::unpack8(*(const u32x4*)(GG + go), g0, g1);
            f32x4 y0, y1;
#pragma unroll
            for (int e = 0; e < 4; ++e) { y0[e] = (HF[r * XC_LD + c8 + e] + HB[r * XC_LD + c8 + e]) * g0[e]; y1[e] = (HF[r * XC_LD + c8 + 4 + e] + HB[r * XC_LD + c8 + 4 + e]) * g1[e]; }
            *(u32x4*)(YB + go) = pg8::pack8(y0, y1);
        }
    }
    __syncthreads();
}

__device__ __forceinline__ void scan_phase(const Ptrs& P, unsigned char* ws, int l, int gt) {
    if (gt < 5 * SG * 2 * SP) {
        const int p = gt & 63, d = (gt >> 6) & 1, g = (gt >> 7) & 63, sq = gt >> 13;
        const int c_lo = sq == 0 ? 0 : 256 + 128 * (sq - 1), n = sq == 0 ? 256 : 128;
        const size_t o = ((size_t)(l * 2 + d) * SG + g) * SP + p;
        const float dt = expf(P.s5_log_dt()[(l * 2 + d) * SG + g]);
        const float x = P.s5_a_re()[o] * dt * 32.0f, y = P.s5_a_im()[o] * dt * 32.0f;
        const float e = expf(x); float sn, cs; sincosf(y, &sn, &cs);
        const float ar = e * cs, ai = e * sn;
        const float* Sb = (const float*)(ws + WS_R + R_SBUF) + (size_t)g * NCR * 256 + d * 128 + p;
        bf16_t* Hb = (bf16_t*)(ws + WS_R + R_UH) + (size_t)g * NCR * UHW + 512 + d * 128 + p;
        float hr = 0.f, hi = 0.f;
        for (int c0 = 0; c0 < n; c0 += 8) {
            float sr[8], si[8];
#pragma unroll
            for (int j = 0; j < 8; ++j) { const int cr = d ? c_lo + n - 1 - (c0 + j) : c_lo + c0 + j; sr[j] = Sb[(size_t)cr * 256]; si[j] = Sb[(size_t)cr * 256 + 64]; }
#pragma unroll
            for (int j = 0; j < 8; ++j) { const int cr = d ? c_lo + n - 1 - (c0 + j) : c_lo + c0 + j;
                Hb[(size_t)cr * UHW] = (bf16_t)(cvt_pk_bf16(hr, 0.f) & 0xffffu); Hb[(size_t)cr * UHW + 64] = (bf16_t)(cvt_pk_bf16(hi, 0.f) & 0xffffu);
                const float nr = ar * hr - ai * hi + sr[j], ni = ar * hi + ai * hr + si[j]; hr = nr; hi = ni; }
        }
    } else if (gt < 5 * SG * 2 * SP + 5 * 2 * 1024) {
        const int t = gt - 5 * SG * 2 * SP, ch = t & 1023, d = (t >> 10) & 1, sq = t >> 11;
        const int c_lo = sq == 0 ? 0 : 64 + 32 * (sq - 1), n = sq == 0 ? 64 : 32;
        const float* Ls = (const float*)(ws + WS_R + R_LSUM) + ((size_t)d * NTC * 1024 + ch) * 2;
        float* Ci = (float*)(ws + WS_R + R_CIN) + (size_t)d * NTC * 1024 + ch;
        float carry = 0.f;
        for (int c0 = 0; c0 < n; c0 += 8) {
            f32x2 ab[8];
#pragma unroll
            for (int j = 0; j < 8; ++j) { const int tc = d ? c_lo + n - 1 - (c0 + j) : c_lo + c0 + j; ab[j] = *(const f32x2*)(Ls + (size_t)tc * 2048); }
#pragma unroll
            for (int j = 0; j < 8; ++j) { const int tc = d ? c_lo + n - 1 - (c0 + j) : c_lo + c0 + j; Ci[(size_t)tc * 1024] = carry; carry = ab[j][0] * carry + ab[j][1]; }
        }
    }
}

__device__ __forceinline__ void fix_phase(const Ptrs& P, unsigned char* ws, int l, int gt, int ngt) {
    const float* EDGE = (const float*)(ws + WS_R + R_EDGE); bf16_t* ACT = (bf16_t*)(ws + WS_R + R_ACT); const float* cw = P.ffn_conv_w() + (size_t)l * 3 * F2;
    const int total = 95 * 2 * (FH / 4);
    for (int idx = gt; idx < total; idx += ngt) {
        const int c4 = (idx % (FH / 4)) * 4, rb = idx / (FH / 4), which = rb & 1, b = (rb >> 1) + 1, row = b * 256;
        if (seq_start(row)) continue;
        const float* e0 = which ? EDGE + ((size_t)(b - 1) * 4 + 3) * 2 * FH : EDGE + ((size_t)(b - 1) * 4 + 2) * 2 * FH;
        const float* e1 = which ? EDGE + ((size_t)b * 4 + 0) * 2 * FH : EDGE + ((size_t)(b - 1) * 4 + 3) * 2 * FH;
        const float* e2 = which ? EDGE + ((size_t)b * 4 + 1) * 2 * FH : EDGE + ((size_t)b * 4 + 0) * 2 * FH;
        f32x4 hg, hv;
        {
            const f32x4 p = *(const f32x4*)(e0 + c4), c = *(const f32x4*)(e1 + c4), n = *(const f32x4*)(e2 + c4);
            hg = *(const f32x4*)(cw + c4) * p + *(const f32x4*)(cw + F2 + c4) * c + *(const f32x4*)(cw + 2 * F2 + c4) * n;
            const f32x4 pv = *(const f32x4*)(e0 + FH + c4), cv = *(const f32x4*)(e1 + FH + c4), nv = *(const f32x4*)(e2 + FH + c4);
            hv = *(const f32x4*)(cw + FH + c4) * pv + *(const f32x4*)(cw + F2 + FH + c4) * cv + *(const f32x4*)(cw + 2 * F2 + FH + c4) * nv;
        }
        u32x2 o; o.x = cvt_pk_bf16(gelu_tanh(hg[0]) * hv[0], gelu_tanh(hg[1]) * hv[1]); o.y = cvt_pk_bf16(gelu_tanh(hg[2]) * hv[2], gelu_tanh(hg[3]) * hv[3]);
        *(u32x2*)(ACT + (size_t)(which ? row : row - 1) * FH + c4) = o;
    }
}

__global__ void __launch_bounds__(512, 2) fwd(Args args) {
    extern __shared__ __attribute__((aligned(16))) unsigned char lds[];
    const int tid = threadIdx.x;
    const int G = gridDim.x, bx = blockIdx.x;
    const int ngw = G * 8, ngt = G * 512;
#define WAVE_OF(td) __builtin_amdgcn_readfirstlane((td) >> 6)
    unsigned char* ws = args.ws;
    Ptrs P; P.a = &args;
    float* X = args.out;
    LAS unsigned char* ldsl = (LAS unsigned char*)lds;
    volatile LAS unsigned* MISC = (volatile LAS unsigned*)(ldsl + MISC_OFF);
    if (tid < 64) MISC[tid] = 0u;
    __syncthreads();
    const int lo = args.ph_lo, hi = args.ph_hi;
    XcdBarrier bar; bar.bar = (unsigned*)(ws + WS_CTL) + CW_BAR; bar.x = 0; bar.st = MISC + 8;
    if (hi - lo > 1) bar = xcd_barrier_post((unsigned*)(ws + WS_CTL) + CW_BAR, MISC + 8);
#ifndef PH_MASK
#define PH_MASK 0xFFFF
#endif
#define EN(k) (((PH_MASK) >> (k)) & 1)
#define RUN(p) (lo <= (p) && (p) < hi)
#define SEAM(p) do { if (RUN(p) && RUN((p) + 1)) xcd_barrier(bar); } while (0)

    bf16_t* XN = (bf16_t*)(ws + WS_XN);
    bf16_t* UH = (bf16_t*)(ws + WS_R + R_UH); bf16_t* XR = (bf16_t*)(ws + WS_R + R_XR); bf16_t* TMP = (bf16_t*)(ws + WS_R + R_TMP); bf16_t* GG = (bf16_t*)(ws + WS_R + R_GG);
    bf16_t* SGA = (bf16_t*)(ws + WS_R + R_SGA); bf16_t* SGB = (bf16_t*)(ws + WS_R + R_SGB); float* SBUF = (float*)(ws + WS_R + R_SBUF); bf16_t* YA = (bf16_t*)(ws + WS_R + R_YA);
    bf16_t* YG = (bf16_t*)(ws + WS_R + R_YG); bf16_t* YB = (bf16_t*)(ws + WS_R + R_YB); bf16_t* ACT = (bf16_t*)(ws + WS_R + R_ACT); float* EDGE = (float*)(ws + WS_R + R_EDGE);

    if (EN(0) && RUN(0)) {
        const int td = opaque(tid), lane = td & 63, wave = WAVE_OF(td), gw = bx * 8 + wave, gt = bx * 512 + td;
        for (int it = bx; it < DEPTH * SG; it += G) s5_prep_item(P, ws, it / SG, it % SG, (float*)lds, td);
        lru_prep(P, ws, gt, ngt);
        float* scr = (float*)(lds + wave * 16384);
        transpose_all(P.w_in(), D, INC, ws, WL_IN, false, scr, lane, gw, ngw);
        transpose_all(P.s5_w_glu(), 1024, 1024, ws, WL_GLU, false, scr, lane, gw, ngw);
        transpose_all(P.w_proj_a(), 1024, D, ws, WL_PA, false, scr, lane, gw, ngw);
        transpose_all(P.w_proj_b(), 1024, D, ws, WL_PB, false, scr, lane, gw, ngw);
        transpose_all(P.w_out(), D, D, ws, WL_OUT, false, scr, lane, gw, ngw);
        transpose_all(P.ffn_w_up(), D, F2, ws, WL_UP, true, scr, lane, gw, ngw);
        transpose_all(P.ffn_w_down(), FH, D, ws, WL_DOWN, false, scr, lane, gw, ngw);
        __syncthreads();
    }
    SEAM(0);

#pragma unroll 1
    for (int l = 0; l < DEPTH; ++l) {
        const int pb = 1 + l * NPH_LAYER;
        unsigned char* wl = ws + WS_W + (size_t)l * WL_STRIDE;
        if (EN(1) && RUN(pb + 0)) { const int td = opaque(tid), ln = td & 63, gw = bx * 8 + WAVE_OF(td); if (l == 0) norm_phase<1>(P, X, XN, P.norm1_g(), gw, ngw, ln); else norm_phase<0>(P, X, XN, P.norm1_g() + (size_t)l * D, gw, ngw, ln); }
        SEAM(pb + 0);
        if (EN(2) && RUN(pb + 1)) {
            pg8::Gemm g{XN, (const bf16_t*)(wl + WL_IN), D, D, D}; pg8::OrderMN S; S.init(T, INC, G, bx);
            pg8::EpiIn E{UH, XR, GG, SGA, SGB};
            pg8::gemm_phase(ldsl, g, S, E);
        }
        SEAM(pb + 1);
        if (EN(3) && RUN(pb + 2)) {
#ifndef NO_SG
            { pg8::Gemm g{UH, (const bf16_t*)(ws + WS_S5 + (size_t)l * S5_STRIDE + S5_BT1), UHW, 512, 512}; pg8::OrderBatched<3, 1, NCR, 256, SG> S; S.init(G, bx);
              pg8::EpiS1 E{SBUF}; pg8::gemm_phase(ldsl, g, S, E); }
#endif
#ifndef NO_LRU
            { const int td = opaque(tid); for (int u = bx; u < NTC * 16; u += G) lru_unit<1>(P, ws, l, u >> 4, u & 15, lds, td); }
#endif
        }
        SEAM(pb + 2);
        if (EN(4) && RUN(pb + 3)) scan_phase(P, ws, l, bx * 512 + opaque(tid));
        SEAM(pb + 3);
        if (EN(5) && RUN(pb + 4)) {
#ifndef NO_SG
            { pg8::Gemm g{UH, (const bf16_t*)(ws + WS_S5 + (size_t)l * S5_STRIDE + S5_BT2), UHW, UHW, UHW}; pg8::OrderBatched<3, 2, NCR, 512, SG> S; S.init(G, bx);
              pg8::EpiS2 E{YG}; pg8::gemm_phase(ldsl, g, S, E); }
#endif
#ifndef NO_LRU
            { const int td = opaque(tid); for (int u = bx; u < NTC * 16; u += G) lru_unit<2>(P, ws, l, u >> 4, u & 15, lds, td); }
#endif
        }
        SEAM(pb + 4);
        if (EN(6) && RUN(pb + 5)) {
            { pg8::Gemm g{YG, (const bf16_t*)(wl + WL_GLU), 1024, 1024, 1024}; pg8::OrderMN S; S.init(T, 1024, G, bx); pg8::EpiMul<0> E{YA, YG, 1024}; pg8::gemm_phase(ldsl, g, S, E); }
            { pg8::Gemm g{YB, (const bf16_t*)(wl + WL_PB), 1024, 1024, 1024}; pg8::OrderMN S; S.init(T, D, G, bx); pg8::EpiMul<1> E{TMP, SGB, D}; pg8::gemm_phase(ldsl, g, S, E); }
        }
        SEAM(pb + 5);
        if (EN(7) && RUN(pb + 6)) { pg8::Gemm g{YA, (const bf16_t*)(wl + WL_PA), 1024, 1024, 1024}; pg8::OrderMN S; S.init(T, D, G, bx); pg8::EpiMul<2> E{TMP, SGA, D}; pg8::gemm_phase(ldsl, g, S, E); }
        SEAM(pb + 6);
        if (EN(8) && RUN(pb + 7)) { pg8::Gemm g{TMP, (const bf16_t*)(wl + WL_OUT), D, D, D}; pg8::OrderMN S; S.init(T, D, G, bx); pg8::EpiRes E{X}; pg8::gemm_phase(ldsl, g, S, E); }
        SEAM(pb + 7);
        if (EN(9) && RUN(pb + 8)) { const int td = opaque(tid); norm_phase<0>(P, X, XN, P.norm2_g() + (size_t)l * D, bx * 8 + WAVE_OF(td), ngw, td & 63); }
        SEAM(pb + 8);
        if (EN(10) && RUN(pb + 9)) {
            pg8::Gemm g{XN, (const bf16_t*)(wl + WL_UP), D, D, D}; pg8::OrderMN S; S.init(T, F2, G, bx);
            pg8::EpiUp E{ACT, EDGE, P.ffn_conv_w() + (size_t)l * 3 * F2, (LAS float*)(ldsl + XCH_OFF)};
            pg8::gemm_phase(ldsl, g, S, E);
        }
        SEAM(pb + 9);
        if (EN(11) && RUN(pb + 10)) fix_phase(P, ws, l, bx * 512 + opaque(tid), ngt);
        SEAM(pb + 10);
        if (EN(12) && RUN(pb + 11)) { pg8::Gemm g{ACT, (const bf16_t*)(wl + WL_DOWN), FH, FH, FH}; pg8::OrderMN S; S.init(T, D, G, bx); pg8::EpiRes E{X}; pg8::gemm_phase(ldsl, g, S, E); }
        SEAM(pb + 11);
    }
    if (EN(13) && RUN(NPHASE - 1)) { const int td = opaque(tid); norm_phase<2>(P, X, XN, P.final_g(), bx * 8 + WAVE_OF(td), ngw, td & 63); }
#undef RUN
#undef SEAM
}

extern "C" void kernel_launch(void* const* d_in, const int* in_sizes, int n_in, void* d_out, int out_size, void* d_ws, size_t ws_size, hipStream_t stream) {
    static int grid = 0;
    if (grid == 0) {
        if (n_in != 28 || out_size != T * D || ws_size < WS_END) { fprintf(stderr, "kernel_launch: unexpected shapes: n_in %d out %d ws %zu (need %zu)\n", n_in, out_size, ws_size, (size_t)WS_END); grid = -1; return; }
        int dev = 0, cus = 0, per_cu = 0;
        if (hipGetDevice(&dev) != hipSuccess || hipDeviceGetAttribute(&cus, hipDeviceAttributeMultiprocessorCount, dev) != hipSuccess) { grid = -1; return; }
        if (hipFuncSetAttribute((const void*)fwd, hipFuncAttributeMaxDynamicSharedMemorySize, LDS_BYTES) != hipSuccess) { fprintf(stderr, "kernel_launch: hipFuncSetAttribute failed\n"); grid = -1; return; }
        if (hipOccupancyMaxActiveBlocksPerMultiprocessor(&per_cu, (const void*)fwd, 512, LDS_BYTES) != hipSuccess || per_cu < 1) { fprintf(stderr, "kernel_launch: occupancy query says %d\n", per_cu); }
        (void)hipGetLastError();
        grid = cus;
    }
    if (grid < 0) return;
    (void)hipMemsetAsync((char*)d_ws + WS_CTL, 0, CTL_BYTES, stream);
    Args a{};
    for (int i = 0; i < 28; ++i) a.in[i] = (const float*)d_in[i];
    a.out = (float*)d_out; a.ws = (unsigned char*)d_ws;
#if MK_ONE_LAUNCH
    a.ph_lo = 0; a.ph_hi = NPHASE;
    hipLaunchKernelGGL(fwd, dim3(grid), dim3(512), LDS_BYTES, stream, a);
#else
    for (int p = 0; p < NPHASE; ++p) { a.ph_lo = p; a.ph_hi = p + 1; hipLaunchKernelGGL(fwd, dim3(grid), dim3(512), LDS_BYTES, stream, a); }
#endif
}
```

```cpp
#include <hip/hip_runtime.h>
#include <cstdio>
#include <cstdint>

#ifndef MK_ONE_LAUNCH
#define MK_ONE_LAUNCH 1
#endif

#define LAS __attribute__((address_space(3)))
#define GAS __attribute__((address_space(1)))
typedef unsigned short bf16_t;
typedef short bf16x8 __attribute__((ext_vector_type(8)));
typedef float f32x4 __attribute__((ext_vector_type(4)));
typedef float f32x2 __attribute__((ext_vector_type(2)));
typedef unsigned u32x4 __attribute__((ext_vector_type(4)));
typedef unsigned u32x2 __attribute__((ext_vector_type(2)));

constexpr int D = 2048, T = 24576, DEPTH = 4, INC = 7168, FH = 6144, F2 = 12288;
constexpr int SG = 64, SP = 64, SH = 16, SL = 32;
constexpr int NCR = T / SL;
constexpr int UHW = SL * SH + 4 * SP;
constexpr int LT = 128, NTC = T / LT;
constexpr float EPS = 1e-6f;
constexpr int NPH_LAYER = 12, NPHASE = 2 + DEPTH * NPH_LAYER;

constexpr size_t MiB = 1u << 20;
constexpr size_t WS_CTL = 0, CTL_BYTES = 1 * MiB;
constexpr size_t WS_W = 2 * MiB;
constexpr size_t WL_IN = 0, WL_GLU = 28 * MiB, WL_PA = 30 * MiB, WL_PB = 34 * MiB, WL_OUT = 38 * MiB, WL_UP = 46 * MiB, WL_DOWN = 94 * MiB, WL_STRIDE = 118 * MiB;
constexpr size_t WS_S5 = WS_W + DEPTH * WL_STRIDE;
constexpr size_t S5_BT1 = 0, S5_BT2 = 16 * MiB, S5_STRIDE = 64 * MiB;
constexpr size_t WS_LRUW = WS_S5 + DEPTH * S5_STRIDE;
constexpr size_t LRUW_STRIDE = 512 * 1024;
constexpr size_t WS_XN = WS_LRUW + 2 * MiB;
constexpr size_t WS_R = WS_XN + 96 * MiB;
constexpr size_t R_UH = 0, R_XR = 72 * MiB, R_TMP = 0  , R_GG = 120 * MiB, R_SGA = 168 * MiB, R_SGB = 264 * MiB, R_SBUF = 360 * MiB, R_YA = 360 * MiB  ,
                 R_YG = 408 * MiB, R_YB = 456 * MiB, R_LSUM = 504 * MiB, R_CIN = 508 * MiB, R_MIX_END = 510 * MiB;
constexpr size_t R_ACT = 0, R_EDGE = 288 * MiB, R_FFN_END = 307 * MiB;
constexpr size_t WS_END = WS_R + R_MIX_END;
static_assert((size_t)SG * NCR * UHW * 2 == 72 * MiB && (size_t)T * 1024 * 2 == 48 * MiB && (size_t)SG * NCR * 256 * 4 == 48 * MiB, "sizes");
static_assert((size_t)96 * 4 * 2 * FH * 4 <= 19 * MiB && R_FFN_END <= R_MIX_END, "ffn overlay");

constexpr int CW_BAR = 4096;

constexpr int STAGE_BYTES = 131072, XCH_OFF = 131072, XCH_BYTES = 8192, MISC_OFF = XCH_OFF + XCH_BYTES, LDS_BYTES = 147456;

__device__ __forceinline__ unsigned cvt_pk_bf16(float lo, float hi) { unsigned r; asm volatile("v_cvt_pk_bf16_f32 %0, %1, %2" : "=v"(r) : "v"(lo), "v"(hi)); return r; }
__device__ __forceinline__ float bf_lo(unsigned w) { return __uint_as_float(w << 16); }
__device__ __forceinline__ float bf_hi(unsigned w) { return __uint_as_float(w & 0xffff0000u); }
__device__ __forceinline__ float fast_sigmoid(float x) { return __builtin_amdgcn_rcpf(1.0f + __expf(-x)); }
__device__ __forceinline__ float gelu_tanh(float x) { const float z = 1.5957691216f * (x + 0.044715f * x * x * x); return x * __builtin_amdgcn_rcpf(1.0f + __expf(-z)); }
__device__ __forceinline__ float wave_sum(float v) {
#pragma unroll
    for (int o = 1; o < 64; o <<= 1) v += __shfl_xor(v, o);
    return v;
}
__device__ __forceinline__ int opaque(int v) { asm volatile("" : "+v"(v)); return v; }
template <int CTRL> __device__ __forceinline__ float dppf(float x) { return __builtin_bit_cast(float, __builtin_amdgcn_update_dpp(0, __builtin_bit_cast(int, x), CTRL, 0xf, 0xf, false)); }

#define XB_TMO      128
#define XB_XCNT(j)  (256  + 64 * (j))
#define XB_XSUB(j)  (1280 + 64 * (j))
#define XB_XGEN(j)  (2304 + 64 * (j))
#define XB_TOP      3328
#define XB_TOPGEN   3392
#define XCD_BAR_WORDS 3456
#define XB_SPIN_CAP (1u << 20)
__device__ __forceinline__ unsigned xb_ld(unsigned* p)              { return __hip_atomic_load(p, __ATOMIC_RELAXED, __HIP_MEMORY_SCOPE_AGENT); }
__device__ __forceinline__ unsigned xb_add(unsigned* p, unsigned v) { return __hip_atomic_fetch_add(p, v, __ATOMIC_RELAXED, __HIP_MEMORY_SCOPE_AGENT); }
__device__ __forceinline__ unsigned xb_xcc_id() { return (unsigned)__builtin_amdgcn_s_getreg((3 << 11) | 20) & 0xFu; }
#define XB_SPIN(cond, bar) do { unsigned _sp = 0; while (cond) { __builtin_amdgcn_s_sleep(1); \
    if ((++_sp & 255u) == 0u) { if (xb_ld(&(bar)[XB_TMO])) break; if (_sp > XB_SPIN_CAP) { atomicAdd(&(bar)[XB_TMO], 1u); break; } } } } while (0)
struct XcdBarrier { unsigned* bar; unsigned x; volatile LAS unsigned* st; };
__device__ __forceinline__ XcdBarrier xcd_barrier_post(unsigned* bar, volatile LAS unsigned* st) {
    XcdBarrier b; b.bar = bar; b.x = xb_xcc_id(); b.st = st;
    if (threadIdx.x == 0) (void)xb_add(&bar[XB_XCNT(b.x)], 1u);
    return b;
}
__device__ __forceinline__ void xcd_barrier_complete(unsigned* bar, unsigned x, unsigned& nloc, unsigned& nx) {
    const unsigned G = gridDim.x * gridDim.y * gridDim.z;
    unsigned sum, cnt, mine, sp = 0u;
    for (;;) {
        sum = 0u; cnt = 0u; mine = 0u;
#pragma unroll
        for (unsigned j = 0; j < 16; ++j) { const unsigned c = xb_ld(&bar[XB_XCNT(j)]); sum += c; cnt += (c > 0u) ? 1u : 0u; mine = (j == x) ? c : mine; }
        if (sum == G) break;
        __builtin_amdgcn_s_sleep(1);
        if ((++sp & 255u) == 0u) { if (xb_ld(&bar[XB_TMO])) break; if (sp > XB_SPIN_CAP) { atomicAdd(&bar[XB_TMO], 1u); break; } }
    }
    nloc = mine > 0u ? mine : 1u; nx = cnt > 0u ? cnt : 1u;
}
__device__ __forceinline__ void xcd_barrier(const XcdBarrier& b) {
    asm volatile("s_waitcnt vmcnt(0)" ::: "memory");
    __syncthreads();
    if (threadIdx.x == 0) {
        unsigned* bar = b.bar;
        __builtin_amdgcn_s_waitcnt(0);
        unsigned nloc = b.st[0], nx = b.st[1];
        if (nloc == 0u) { xcd_barrier_complete(bar, b.x, nloc, nx); b.st[0] = nloc; b.st[1] = nx; }
        const unsigned old = xb_add(&bar[XB_XSUB(b.x)], 1u);
        const unsigned gen = old / nloc;
        if (old + 1u == (gen + 1u) * nloc) {
            __builtin_amdgcn_fence(__ATOMIC_RELEASE, "agent");
            asm volatile("s_waitcnt vmcnt(0)" ::: "memory");
            const unsigned og = xb_add(&bar[XB_TOP], 1u);
            const unsigned tg = og / nx;
            if (og + 1u == (tg + 1u) * nx) xb_add(&bar[XB_TOPGEN], 1u);
            else XB_SPIN(xb_ld(&bar[XB_TOPGEN]) == tg, bar);
            __builtin_amdgcn_fence(__ATOMIC_ACQUIRE, "agent");
            xb_add(&bar[XB_XGEN(b.x)], 1u);
            asm volatile("s_waitcnt vmcnt(0)" ::: "memory");
        } else {
            XB_SPIN(xb_ld(&bar[XB_XGEN(b.x)]) == gen, bar);
            __builtin_amdgcn_fence(__ATOMIC_ACQUIRE, "agent");
            asm volatile("s_waitcnt vmcnt(0)" ::: "memory");
        }
    }
    __syncthreads();
}

namespace pg8 {
constexpr int BM = 256, BK = 64, HALF = 128, HTB = HALF * BK * 2, NXCD = 8, WGM = 8;
__host__ __device__ __forceinline__ int lds_byte(int r, int c) { const int st = (r >> 4) * 2 + (c >> 5), rr = r & 15, cc = c & 31, ob = rr * 64 + cc * 2; return st * 1024 + (ob ^ (((ob >> 9) & 1) << 5)); }
__host__ __device__ __forceinline__ void stage_rc(int b, int& R, int& C) { const int st = b / 1024, sb = b % 1024, swz = sb ^ (((sb >> 9) & 1) << 5); R = (st >> 1) * 16 + swz / 64; C = (st & 1) * 32 + (swz % 64) / 2; }
__host__ __device__ __forceinline__ int perm32(int rho) { const int n = rho >> 4, i = rho & 15; return 8 * (i >> 2) + 4 * n + (i & 3); }

struct Unit { int arow, brow, pm, pn, g; };
struct Gemm { const bf16_t* A; const bf16_t* Bt; int lda, ldb, K; };

struct OrderMN {
    int nM, nN, nwg, G, c;
    __device__ void init(int M, int N, int G_, int c_) { nM = M / BM; nN = N / BM; nwg = nM * nN; G = G_; c = c_; }
    __device__ bool next(int i, Unit& u) const {
        const long L = (long)i * G + c; if (L >= nwg) return false;
        int wgid = (int)L; { const int q = nwg / NXCD, r = nwg % NXCD, xcd = wgid % NXCD, off = wgid / NXCD; wgid = (xcd < r ? xcd * (q + 1) : r * (q + 1) + (xcd - r) * q) + off; }
        const int nig = WGM * nN, gid = wgid / nig, fm = gid * WGM, gsz = (nM - fm) < WGM ? (nM - fm) : WGM;
        u.pm = fm + ((wgid % nig) % gsz); u.pn = (wgid % nig) / gsz; u.g = 0; u.arow = u.pm * BM; u.brow = u.pn * BM; return true;
    }
};
template <int NM, int NN, int AR, int BR, int NG> struct OrderBatched {
    int G, c;
    __device__ void init(int G_, int c_) { G = G_; c = c_; }
    __device__ bool next(int i, Unit& u) const {
        const int L = i * G + c; if (L >= NG * NM * NN) return false;
        const int g = L / (NM * NN), r = L % (NM * NN); u.g = g; u.pm = r % NM; u.pn = r / NM; u.arow = g * AR + u.pm * BM; u.brow = g * BR + u.pn * BM; return true;
    }
};

template <class Epi, class Sched>
__device__ __forceinline__ void gemm_phase(LAS unsigned char* lds, const Gemm g, const Sched& S, const Epi& E) {
    const int tid = opaque((int)threadIdx.x), wid = __builtin_amdgcn_readfirstlane(tid >> 6), lane = tid & 63, wr = wid >> 2, wc = wid & 3, fr = lane & 15, fq = lane >> 4;
    const int K = g.K, nt = K / BK;
    unsigned voffA[2], voffB[2];
#pragma unroll
    for (int i = 0; i < 2; ++i) { int R, C; stage_rc(tid * 16 + i * 8192, R, C); const int Rb = Epi::PERM ? ((R & ~31) + perm32(R & 31)) : R;
        voffA[i] = (unsigned)(R * g.lda + C) * 2u; voffB[i] = (unsigned)(Rb * g.ldb + C) * 2u; }
    const size_t kstep = (size_t)(BK * 2);
    const size_t hstepA = (size_t)HALF * g.lda * 2, hstepB = (size_t)HALF * g.ldb * 2;
    const size_t rstepA = (size_t)g.lda * 2, rstepB = (size_t)g.ldb * 2;
    const unsigned ldsw = (unsigned)wid * 1024u;
    const int aoff = lds_byte(wr * 64 + fr, fq * 8), boff = lds_byte(wc * 32 + fr, fq * 8);
#define PG8_SA(b, h) (((b) * 2 + (h)) * HTB)
#define PG8_SB(b, h) ((4 + (b) * 2 + (h)) * HTB)
#define PG8_STAGE(bufoff, gbase, voff) do { _Pragma("unroll") for (int _i = 0; _i < 2; ++_i) \
        __builtin_amdgcn_global_load_lds((const unsigned*)((const char*)(gbase) + (voff)[_i]), (LAS unsigned*)(lds + (bufoff) + ldsw + _i * 8192), 16, 0, 0); } while (0)
#define PG8_LDA(dst, b, h) do { _Pragma("unroll") for (int m = 0; m < 4; ++m) _Pragma("unroll") for (int k = 0; k < 2; ++k) dst[m][k] = *(const LAS bf16x8*)(lds + PG8_SA(b, h) + aoff + m * 2048 + k * 1024); } while (0)
#define PG8_LDB(dst, b, h) do { _Pragma("unroll") for (int n = 0; n < 2; ++n) _Pragma("unroll") for (int k = 0; k < 2; ++k) dst[n][k] = *(const LAS bf16x8*)(lds + PG8_SB(b, h) + boff + n * 2048 + k * 1024); } while (0)
#define PG8_MMA(ai, bj, At, Bt) do { __builtin_amdgcn_s_setprio(1); _Pragma("unroll") for (int m = 0; m < 4; ++m) _Pragma("unroll") for (int n = 0; n < 2; ++n) _Pragma("unroll") for (int k = 0; k < 2; ++k) \
        acc[ai][bj][m][n] = __builtin_amdgcn_mfma_f32_16x16x32_bf16(Bt[n][k], At[m][k], acc[ai][bj][m][n], 0, 0, 0); __builtin_amdgcn_s_setprio(0); } while (0)
#define PG8_WAIT_V(n) asm volatile("s_waitcnt vmcnt(" #n ")" ::: "memory")
#define PG8_WAIT_L(n) asm volatile("s_waitcnt lgkmcnt(" #n ")" ::: "memory")
#define PG8_BAR __builtin_amdgcn_s_barrier()
#define PG8_SCHED __builtin_amdgcn_sched_barrier(0)
    Unit cur, nxt; int ui = 0;
    if (!S.next(0, cur)) return;
    f32x4 acc[2][2][4][2];
#pragma unroll
    for (int a = 0; a < 2; ++a)
#pragma unroll
        for (int b = 0; b < 2; ++b)
#pragma unroll
            for (int m = 0; m < 4; ++m)
#pragma unroll
                for (int n = 0; n < 2; ++n) acc[a][b][m][n] = (f32x4){0.f, 0.f, 0.f, 0.f};
    bf16x8 At[4][2], B0[2][2], B1[2][2];
    const char* cA = (const char*)g.A + (size_t)cur.arow * rstepA; const char* cB = (const char*)g.Bt + (size_t)cur.brow * rstepB;
    PG8_STAGE(PG8_SB(0, 0), cB, voffB); PG8_STAGE(PG8_SB(0, 1), cB + hstepB, voffB); PG8_STAGE(PG8_SA(0, 0), cA, voffA); PG8_STAGE(PG8_SA(0, 1), cA + hstepA, voffA);
    if (wr == 1) PG8_BAR;
    PG8_WAIT_V(2); PG8_BAR;
    PG8_STAGE(PG8_SB(1, 0), cB + kstep, voffB); PG8_STAGE(PG8_SA(1, 0), cA + kstep, voffA); PG8_STAGE(PG8_SB(1, 1), cB + hstepB + kstep, voffB);
    PG8_WAIT_V(6); PG8_BAR;
    for (;;) {
        const bool has_next = S.next(ui + 1, nxt);
        const char* nA = has_next ? (const char*)g.A + (size_t)nxt.arow * rstepA : cA; const char* nB = has_next ? (const char*)g.Bt + (size_t)nxt.brow * rstepB : cB;
        for (int t = 0; t < nt; t += 2) {
            const bool last = (t == nt - 2);
            const char* a1 = cA + (size_t)(t + 1) * kstep;
            const char* a2 = last ? nA : cA + (size_t)(t + 2) * kstep; const char* b2 = last ? nB : cB + (size_t)(t + 2) * kstep;
            const char* a3 = a2 + kstep; const char* b3 = b2 + kstep;
            PG8_LDB(B0, 0, 0); PG8_LDB(B1, 0, 1); PG8_SCHED; PG8_LDA(At, 0, 0); PG8_STAGE(PG8_SA(1, 1), a1 + hstepA, voffA);
            PG8_WAIT_V(8); PG8_WAIT_L(0); PG8_BAR; PG8_MMA(0, 0, At, B0); PG8_MMA(0, 1, At, B1); PG8_BAR; PG8_SCHED;
            PG8_LDA(At, 0, 1); PG8_STAGE(PG8_SB(0, 0), b2, voffB); PG8_STAGE(PG8_SB(0, 1), b2 + hstepB, voffB); PG8_STAGE(PG8_SA(0, 0), a2, voffA);
            PG8_WAIT_V(8); PG8_WAIT_L(0); PG8_BAR; PG8_MMA(1, 0, At, B0); PG8_MMA(1, 1, At, B1); PG8_BAR; PG8_SCHED;
            PG8_LDB(B0, 1, 0); PG8_LDB(B1, 1, 1); PG8_SCHED; PG8_LDA(At, 1, 0); PG8_STAGE(PG8_SA(0, 1), a2 + hstepA, voffA);
            PG8_WAIT_V(8); PG8_WAIT_L(0); PG8_BAR; PG8_MMA(0, 0, At, B0); PG8_MMA(0, 1, At, B1); PG8_BAR; PG8_SCHED;
            PG8_LDA(At, 1, 1); PG8_STAGE(PG8_SB(1, 0), b3, voffB); PG8_STAGE(PG8_SB(1, 1), b3 + hstepB, voffB); PG8_STAGE(PG8_SA(1, 0), a3, voffA);
            PG8_WAIT_V(8); PG8_WAIT_L(0); PG8_BAR; PG8_MMA(1, 0, At, B0); PG8_MMA(1, 1, At, B1); PG8_BAR; PG8_SCHED;
        }
        if (wr == 0) PG8_BAR;
        E(acc, cur, wr, wc, fr, fq);
        if (!has_next) break;
#pragma unroll
        for (int a = 0; a < 2; ++a)
#pragma unroll
            for (int b = 0; b < 2; ++b)
#pragma unroll
                for (int m = 0; m < 4; ++m)
#pragma unroll
                    for (int n = 0; n < 2; ++n) acc[a][b][m][n] = (f32x4){0.f, 0.f, 0.f, 0.f};
        cur = nxt; cA = nA; cB = nB; ++ui;
        if (wr == 1) PG8_BAR;
    }
    PG8_WAIT_V(0);
    PG8_BAR;
#undef PG8_SA
#undef PG8_SB
#undef PG8_STAGE
#undef PG8_LDA
#undef PG8_LDB
#undef PG8_MMA
#undef PG8_WAIT_V
#undef PG8_WAIT_L
#undef PG8_BAR
#undef PG8_SCHED
}

typedef f32x4 Acc[2][2][4][2];
__device__ __forceinline__ u32x4 pack8(const f32x4 a, const f32x4 b) { u32x4 w; w.x = cvt_pk_bf16(a[0], a[1]); w.y = cvt_pk_bf16(a[2], a[3]); w.z = cvt_pk_bf16(b[0], b[1]); w.w = cvt_pk_bf16(b[2], b[3]); return w; }
__device__ __forceinline__ void unpack8(const u32x4 w, f32x4& a, f32x4& b) { a = (f32x4){bf_lo(w.x), bf_hi(w.x), bf_lo(w.y), bf_hi(w.y)}; b = (f32x4){bf_lo(w.z), bf_hi(w.z), bf_lo(w.w), bf_hi(w.w)}; }

struct EpiIn {
    static constexpr bool PERM = true;
    bf16_t *UH, *XR, *GG, *SGA, *SGB;
    __device__ __forceinline__ void operator()(const Acc& acc, const Unit& u, int wr, int wc, int fr, int fq) const {
        const int pn = u.pn, row0 = u.pm * BM + wr * 64 + fr, cb = pn * BM + wc * 32 + 8 * fq;
        int kind, ld = 1024, coff = 0; bf16_t* base = XR;
        if (pn < 4) kind = 0; else if (pn < 8) { kind = 1; base = XR; coff = cb - 1024; } else if (pn < 12) { kind = 2; base = GG; coff = cb - 2048; }
        else if (pn < 20) { kind = 3; base = SGA; ld = 2048; coff = cb - 3072; } else { kind = 3; base = SGB; ld = 2048; coff = cb - 5120; }
#pragma unroll
        for (int ai = 0; ai < 2; ++ai)
#pragma unroll
            for (int m = 0; m < 4; ++m) { const int r = row0 + ai * HALF + m * 16;
#pragma unroll
                for (int bj = 0; bj < 2; ++bj) { f32x4 v0 = acc[ai][bj][m][0], v1 = acc[ai][bj][m][1];
                    if (kind == 2) {
#pragma unroll
                        for (int j = 0; j < 4; ++j) { v0[j] = gelu_tanh(v0[j]); v1[j] = gelu_tanh(v1[j]); } }
                    else if (kind == 3) {
#pragma unroll
                        for (int j = 0; j < 4; ++j) { v0[j] = fast_sigmoid(v0[j]); v1[j] = fast_sigmoid(v1[j]); } }
                    const u32x4 w = pack8(v0, v1);
                    if (kind == 0) { const int c = cb + bj * HALF, gg = c >> 4; *(u32x4*)(UH + ((size_t)(gg * NCR + (r >> 5)) * UHW + (r & 31) * 16 + (c & 15))) = w; }
                    else *(u32x4*)(base + (size_t)r * ld + coff + bj * HALF) = w; } }
    }
};
struct EpiS1 {
    static constexpr bool PERM = false;
    float* C;
    __device__ __forceinline__ void operator()(const Acc& acc, const Unit& u, int wr, int wc, int fr, int fq) const {
        const int row0 = u.arow + wr * 64 + fr, col0 = wc * 32 + 4 * fq;
#pragma unroll
        for (int ai = 0; ai < 2; ++ai)
#pragma unroll
            for (int m = 0; m < 4; ++m) { float* rowp = C + (size_t)(row0 + ai * HALF + m * 16) * 256 + col0;
#pragma unroll
                for (int bj = 0; bj < 2; ++bj)
#pragma unroll
                    for (int n = 0; n < 2; ++n) *(f32x4*)(rowp + bj * HALF + n * 16) = acc[ai][bj][m][n]; }
    }
};
struct EpiS2 {
    static constexpr bool PERM = true;
    bf16_t* YG;
    __device__ __forceinline__ void operator()(const Acc& acc, const Unit& u, int wr, int wc, int fr, int fq) const {
        const int cr0 = u.pm * BM + wr * 64 + fr, nb = u.pn * BM + wc * 32 + 8 * fq;
#pragma unroll
        for (int ai = 0; ai < 2; ++ai)
#pragma unroll
            for (int m = 0; m < 4; ++m) { const int cr = cr0 + ai * HALF + m * 16;
#pragma unroll
                for (int bj = 0; bj < 2; ++bj) { f32x4 v0 = acc[ai][bj][m][0], v1 = acc[ai][bj][m][1];
#pragma unroll
                    for (int j = 0; j < 4; ++j) { v0[j] = gelu_tanh(v0[j]); v1[j] = gelu_tanh(v1[j]); }
                    const int n = nb + bj * HALF, t = n >> 4, i0 = n & 15;
                    *(u32x4*)(YG + (size_t)(cr * SL + t) * 1024 + u.g * 16 + i0) = pack8(v0, v1); } }
    }
};
template <int MODE> struct EpiMul {
    static constexpr bool PERM = true;
    bf16_t* O; const bf16_t* X1; int ld;
    __device__ __forceinline__ void operator()(const Acc& acc, const Unit& u, int wr, int wc, int fr, int fq) const {
        const int row0 = u.pm * BM + wr * 64 + fr, col0 = u.pn * BM + wc * 32 + 8 * fq;
#pragma unroll
        for (int ai = 0; ai < 2; ++ai)
#pragma unroll
            for (int m = 0; m < 4; ++m) { const size_t ro = (size_t)(row0 + ai * HALF + m * 16) * ld + col0;
#pragma unroll
                for (int bj = 0; bj < 2; ++bj) { f32x4 v0 = acc[ai][bj][m][0], v1 = acc[ai][bj][m][1], x0, x1;
                    unpack8(*(const u32x4*)(X1 + ro + bj * HALF), x0, x1);
                    if (MODE == 0) {
#pragma unroll
                        for (int j = 0; j < 4; ++j) { v0[j] = x0[j] * fast_sigmoid(v0[j]); v1[j] = x1[j] * fast_sigmoid(v1[j]); } }
                    else { v0 = v0 * x0; v1 = v1 * x1; }
                    if (MODE == 2) { f32x4 t0, t1; unpack8(*(const u32x4*)(O + ro + bj * HALF), t0, t1); v0 = v0 + t0; v1 = v1 + t1; }
                    *(u32x4*)(O + ro + bj * HALF) = pack8(v0, v1); } }
    }
};
struct EpiRes {
    static constexpr bool PERM = false;
    float* X;
    __device__ __forceinline__ void operator()(const Acc& acc, const Unit& u, int wr, int wc, int fr, int fq) const {
        const int row0 = u.pm * BM + wr * 64 + fr, col0 = u.pn * BM + wc * 32 + 4 * fq;
#pragma unroll
        for (int ai = 0; ai < 2; ++ai)
#pragma unroll
            for (int m = 0; m < 4; ++m) { float* rowp = X + (size_t)(row0 + ai * HALF + m * 16) * D + col0;
#pragma unroll
                for (int bj = 0; bj < 2; ++bj)
#pragma unroll
                    for (int n = 0; n < 2; ++n) { f32x4* p = (f32x4*)(rowp + bj * HALF + n * 16); *p = *p + acc[ai][bj][m][n]; } }
    }
};
struct EpiUp {
    static constexpr bool PERM = true;
    bf16_t* ACT; float* EDGE; const float* cw;
    LAS float* xch;
    __device__ __forceinline__ void operator()(const Acc& acc, const Unit& u, int wr, int wc, int fr, int fq) const {
        const int wid = wr * 4 + wc, pw = (1 - wr) * 4 + wc;
        const int gc0 = u.pn * HALF + wc * 32 + 8 * fq;
#pragma unroll
        for (int ai = 0; ai < 2; ++ai) {
            if (fr == 0) { LAS f32x4* p = (LAS f32x4*)(xch + (((wid * 2 + ai) * 2 + 0) * 4 + fq) * 16);
                p[0] = acc[ai][0][0][0]; p[1] = acc[ai][0][0][1]; p[2] = acc[ai][1][0][0]; p[3] = acc[ai][1][0][1]; }
            if (fr == 15) { LAS f32x4* p = (LAS f32x4*)(xch + (((wid * 2 + ai) * 2 + 1) * 4 + fq) * 16);
                p[0] = acc[ai][0][3][0]; p[1] = acc[ai][0][3][1]; p[2] = acc[ai][1][3][0]; p[3] = acc[ai][1][3][1]; }
        }
        {
            float* eb = EDGE + (size_t)u.pm * 4 * 2 * FH + gc0;
            if (wr == 0 && fr < 2) {
#pragma unroll
                for (int bj = 0; bj < 2; ++bj) { float* p = eb + (size_t)(fr * 2 + bj) * FH; *(f32x4*)p = acc[0][bj][0][0]; *(f32x4*)(p + 4) = acc[0][bj][0][1]; } }
            if (wr == 1 && fr >= 14) {
#pragma unroll
                for (int bj = 0; bj < 2; ++bj) { float* p = eb + (size_t)((fr - 12) * 2 + bj) * FH; *(f32x4*)p = acc[1][bj][3][0]; *(f32x4*)(p + 4) = acc[1][bj][3][1]; } }
        }
        asm volatile("s_waitcnt lgkmcnt(0)" ::: "memory"); __builtin_amdgcn_s_barrier(); asm volatile("" ::: "memory");
#pragma unroll
        for (int ai = 0; ai < 2; ++ai)
#pragma unroll
            for (int m = 0; m < 4; ++m) {
                const bool up_out = (wr == 0 && ai == 0), dn_out = (wr == 1 && ai == 1);
                const LAS f32x4* pu = (const LAS f32x4*)(xch + (((pw * 2 + ((wr == 0) ? 0 : ai)) * 2 + 1) * 4 + fq) * 16);
                const LAS f32x4* pd = (const LAS f32x4*)(xch + (((pw * 2 + ((wr == 0) ? ai : 1)) * 2 + 0) * 4 + fq) * 16);
                f32x4 o[2];
#pragma unroll
                for (int n = 0; n < 2; ++n) {
                    int zo = 0; asm volatile("" : "+s"(zo));
                    const float* cwp = cw + zo + gc0 + 4 * n;
                    f32x4 h[2];
#pragma unroll
                    for (int bj = 0; bj < 2; ++bj) {
                        const f32x4 w0 = *(const f32x4*)(cwp + bj * FH), w1 = *(const f32x4*)(cwp + F2 + bj * FH), w2 = *(const f32x4*)(cwp + 2 * F2 + bj * FH);
                        f32x4 upv, dnv;
                        if (m > 0) upv = acc[ai][bj][m > 0 ? m - 1 : 0][n]; else upv = up_out ? (f32x4){0.f, 0.f, 0.f, 0.f} : pu[bj * 2 + n];
                        if (m < 3) dnv = acc[ai][bj][m < 3 ? m + 1 : 3][n]; else dnv = dn_out ? (f32x4){0.f, 0.f, 0.f, 0.f} : pd[bj * 2 + n];
#pragma unroll
                        for (int j = 0; j < 4; ++j) {
                            const float cur = acc[ai][bj][m][n][j];
                            const float prev = dppf<0x121>(fr == 15 ? upv[j] : cur);
                            const float next = dppf<0x12F>(fr == 0 ? dnv[j] : cur);
                            h[bj][j] = w0[j] * prev + w1[j] * cur + w2[j] * next;
                        }
                    }
#pragma unroll
                    for (int j = 0; j < 4; ++j) o[n][j] = gelu_tanh(h[0][j]) * h[1][j];
                }
                const int r = u.pm * BM + ai * HALF + wr * 64 + m * 16 + fr;
                *(u32x4*)(ACT + (size_t)r * FH + gc0) = pack8(o[0], o[1]);
            }
    }
};
}

struct Args {
    const float* in[28]; float* out; unsigned char* ws; int ph_lo, ph_hi;
};
struct Ptrs {
    const Args* a;
    __device__ __forceinline__ const float* x_prompt() const { return a->in[0]; }
    __device__ __forceinline__ const float* x_sample() const { return a->in[1]; }
    __device__ __forceinline__ const float* norm1_g() const { return a->in[2]; }
    __device__ __forceinline__ const float* w_in() const { return a->in[3]; }
    __device__ __forceinline__ const float* s5_a_re() const { return a->in[4]; }
    __device__ __forceinline__ const float* s5_a_im() const { return a->in[5]; }
    __device__ __forceinline__ const float* s5_log_dt() const { return a->in[6]; }
    __device__ __forceinline__ const float* s5_b_re() const { return a->in[7]; }
    __device__ __forceinline__ const float* s5_b_im() const { return a->in[8]; }
    __device__ __forceinline__ const float* s5_c_re() const { return a->in[9]; }
    __device__ __forceinline__ const float* s5_c_im() const { return a->in[10]; }
    __device__ __forceinline__ const float* s5_d() const { return a->in[11]; }
    __device__ __forceinline__ const float* s5_w_glu() const { return a->in[12]; }
    __device__ __forceinline__ const float* lru_conv_w() const { return a->in[13]; }
    __device__ __forceinline__ const float* lru_conv_b() const { return a->in[14]; }
    __device__ __forceinline__ const float* lru_w_a() const { return a->in[15]; }
    __device__ __forceinline__ const float* lru_b_a() const { return a->in[16]; }
    __device__ __forceinline__ const float* lru_w_x() const { return a->in[17]; }
    __device__ __forceinline__ const float* lru_b_x() const { return a->in[18]; }
    __device__ __forceinline__ const float* lru_lambda() const { return a->in[19]; }
    __device__ __forceinline__ const float* w_proj_a() const { return a->in[20]; }
    __device__ __forceinline__ const float* w_proj_b() const { return a->in[21]; }
    __device__ __forceinline__ const float* w_out() const { return a->in[22]; }
    __device__ __forceinline__ const float* norm2_g() const { return a->in[23]; }
    __device__ __forceinline__ const float* ffn_w_up() const { return a->in[24]; }
    __device__ __forceinline__ const float* ffn_conv_w() const { return a->in[25]; }
    __device__ __forceinline__ const float* ffn_w_down() const { return a->in[26]; }
    __device__ __forceinline__ const float* final_g() const { return a->in[27]; }
};

__device__ __forceinline__ void transpose_item(const float* W, int K, int N, bf16_t* WT, int k0, int n0s, int n0d, float* scr, int lane) {
#pragma unroll 8
    for (int i = 0; i < 32; ++i) { const int kk = 2 * i + (lane >> 5); scr[kk * 33 + (lane & 31)] = W[(size_t)(k0 + kk) * N + n0s + (lane & 31)]; }
    asm volatile("s_waitcnt lgkmcnt(0)" ::: "memory");
    const int c = lane & 7;
#pragma unroll
    for (int j = 0; j < 4; ++j) { const int n = (lane >> 3) + 8 * j; const float* s = scr + (8 * c) * 33 + n;
        u32x4 o; o.x = cvt_pk_bf16(s[0 * 33], s[1 * 33]); o.y = cvt_pk_bf16(s[2 * 33], s[3 * 33]); o.z = cvt_pk_bf16(s[4 * 33], s[5 * 33]); o.w = cvt_pk_bf16(s[6 * 33], s[7 * 33]);
        *(u32x4*)(WT + (size_t)(n0d + n) * K + k0 + 8 * c) = o; }
    asm volatile("s_waitcnt lgkmcnt(0)" ::: "memory");
}
__device__ __forceinline__ void transpose_all(const float* W, int K, int N, unsigned char* ws, size_t woff, bool up_perm, float* scr, int lane, int gw, int ngw) {
    const int nblk = N / 32, per = (K / 64) * nblk, total = DEPTH * per;
    for (int it = gw; it < total; it += ngw) {
        const int l = it / per, r = it % per, kb = r / nblk, nb = r % nblk, n0d = nb * 32;
        int n0s = n0d;
        if (up_perm) { const int tile = n0d >> 8, wi = n0d & 255; n0s = (wi < 128) ? tile * 128 + wi : FH + tile * 128 + (wi - 128); }
        transpose_item(W + (size_t)l * K * N, K, N, (bf16_t*)(ws + WS_W + (size_t)l * WL_STRIDE + woff), kb * 64, n0s, n0d, scr, lane);
    }
}

__device__ __forceinline__ void s5_prep_item(const Ptrs& P, unsigned char* ws, int l, int g, float* lds, int tid) {
    float* Ktab = lds;
    float* apr = lds + 16384;
    float* api = apr + 2 * 33 * 64;
    float* bbr = api + 2 * 33 * 64;
    float* bbi = bbr + 2 * 64 * 16;
    for (int idx = tid; idx < 2 * 33 * 64; idx += 512) {
        const int d = idx / (33 * 64), r = idx % (33 * 64), tau = r / 64, p = r % 64;
        const size_t o = ((size_t)(l * 2 + d) * SG + g) * SP + p;
        const float dt = __expf(P.s5_log_dt()[(l * 2 + d) * SG + g]);
        const float x = P.s5_a_re()[o] * dt * (float)tau, y = P.s5_a_im()[o] * dt * (float)tau;
        const float e = expf(x); float sn, cs; sincosf(y, &sn, &cs);
        apr[idx] = e * cs; api[idx] = e * sn;
    }
    for (int idx = tid; idx < 2 * 64 * 16; idx += 512) {
        const int d = idx / 1024, p = (idx % 1024) / 16, j = idx % 16;
        const size_t o = ((size_t)(l * 2 + d) * SG + g) * SP + p;
        const float dt = expf(P.s5_log_dt()[(l * 2 + d) * SG + g]);
        const float lr = P.s5_a_re()[o], li = P.s5_a_im()[o], x = lr * dt, y = li * dt;
        float sn, cs; sincosf(y, &sn, &cs); float sh, ch; sincosf(0.5f * y, &sh, &ch);
        const float nr = expm1f(x) * cs - 2.0f * sh * sh, ni = expf(x) * sn;
        const float den = 1.0f / (lr * lr + li * li);
        const float qr = (nr * lr + ni * li) * den, qi = (ni * lr - nr * li) * den;
        const float br = P.s5_b_re()[o * 16 + j], bi = P.s5_b_im()[o * 16 + j];
        bbr[idx] = qr * br - qi * bi; bbi[idx] = qr * bi + qi * br;
    }
    __syncthreads();
    for (int idx = tid; idx < 2 * 32 * 256; idx += 512) {
        const int d = idx / 8192, tau = (idx % 8192) / 256, i = (idx % 256) / 16, j = idx % 16;
        const float* cr = P.s5_c_re() + (((size_t)(l * 2 + d) * SG + g) * SH + i) * SP; const float* ci = P.s5_c_im() + (((size_t)(l * 2 + d) * SG + g) * SH + i) * SP;
        float s = 0.f;
        for (int p = 0; p < 64; ++p) {
            const float ar = apr[(d * 33 + tau) * 64 + p], ai = api[(d * 33 + tau) * 64 + p], br = bbr[(d * 64 + p) * 16 + j], bi = bbi[(d * 64 + p) * 16 + j];
            const float wr_ = ar * br - ai * bi, wi_ = ar * bi + ai * br;
            s += cr[p] * wr_ - ci[p] * wi_;
        }
        Ktab[idx] = s;
    }
    __syncthreads();
    bf16_t* Bt2 = (bf16_t*)(ws + WS_S5 + (size_t)l * S5_STRIDE + S5_BT2) + (size_t)g * 512 * UHW;
    for (int pc = tid; pc < 512 * (UHW / 8); pc += 512) {
        const int n = pc / (UHW / 8), k8 = pc % (UHW / 8), t = n >> 4, i = n & 15;
        float v[8];
        if (k8 < 64) {
            const int s = k8 >> 1, j0 = (k8 & 1) * 8;
#pragma unroll
            for (int e = 0; e < 8; ++e) { const int j = j0 + e; float x;
                if (s < t) x = Ktab[(0 * 32 + (t - s)) * 256 + i * 16 + j];
                else if (s > t) x = Ktab[(1 * 32 + (s - t)) * 256 + i * 16 + j];
                else { x = Ktab[i * 16 + j] + Ktab[8192 + i * 16 + j]; if (i == j) x += P.s5_d()[(size_t)l * 1024 + g * 16 + i]; }
                v[e] = x; }
        } else {
            const int kk = (k8 - 64) * 8, sel = kk >> 6, p0 = kk & 63, d = sel >> 1, ex = d ? (32 - t) : (t + 1);
            const float* cr = P.s5_c_re() + (((size_t)(l * 2 + d) * SG + g) * SH + i) * SP; const float* ci = P.s5_c_im() + (((size_t)(l * 2 + d) * SG + g) * SH + i) * SP;
#pragma unroll
            for (int e = 0; e < 8; ++e) { const int p = p0 + e; const float ar = apr[(d * 33 + ex) * 64 + p], ai = api[(d * 33 + ex) * 64 + p];
                const float wr_ = cr[p] * ar - ci[p] * ai, wi_ = cr[p] * ai + ci[p] * ar;
                v[e] = (sel & 1) ? -wi_ : wr_; }
        }
        u32x4 o; o.x = cvt_pk_bf16(v[0], v[1]); o.y = cvt_pk_bf16(v[2], v[3]); o.z = cvt_pk_bf16(v[4], v[5]); o.w = cvt_pk_bf16(v[6], v[7]);
        *(u32x4*)(Bt2 + (size_t)n * UHW + k8 * 8) = o;
    }
    bf16_t* Bt1 = (bf16_t*)(ws + WS_S5 + (size_t)l * S5_STRIDE + S5_BT1) + (size_t)g * 256 * 512;
    for (int pc = tid; pc < 256 * 64; pc += 512) {
        const int n = pc / 64, k8 = pc % 64, sel = n >> 6, p = n & 63, d = sel >> 1, s = k8 >> 1, j0 = (k8 & 1) * 8, ex = d ? s : (31 - s);
        const float ar = apr[(d * 33 + ex) * 64 + p], ai = api[(d * 33 + ex) * 64 + p];
        float v[8];
#pragma unroll
        for (int e = 0; e < 8; ++e) { const float br = bbr[(d * 64 + p) * 16 + j0 + e], bi = bbi[(d * 64 + p) * 16 + j0 + e];
            v[e] = (sel & 1) ? (ar * bi + ai * br) : (ar * br - ai * bi); }
        u32x4 o; o.x = cvt_pk_bf16(v[0], v[1]); o.y = cvt_pk_bf16(v[2], v[3]); o.z = cvt_pk_bf16(v[4], v[5]); o.w = cvt_pk_bf16(v[6], v[7]);
        *(u32x4*)(Bt1 + (size_t)n * 512 + k8 * 8) = o;
    }
    __syncthreads();
}

__device__ __forceinline__ void lru_prep(const Ptrs& P, unsigned char* ws, int gt, int ngt) {
    const int total = DEPTH * 16 * 8 * 4 * 64;
    for (int idx = gt; idx < total; idx += ngt) {
        const int lane = idx & 63, f = (idx >> 6) & 3, w = (idx >> 8) & 7, hb = (idx >> 11) & 15, l = idx >> 15;
        const int d = w >> 2, cs = w & 3, mat = f >> 1, ks = f & 1;
        const float* W = (mat ? P.lru_w_x() : P.lru_w_a()) + ((size_t)((l * 2 + d) * 16 + hb) * 64) * 64;
        float v[8];
#pragma unroll
        for (int e = 0; e < 8; ++e) v[e] = W[(size_t)(32 * ks + 8 * (lane >> 4) + e) * 64 + 16 * cs + (lane & 15)];
        u32x4 o; o.x = cvt_pk_bf16(v[0], v[1]); o.y = cvt_pk_bf16(v[2], v[3]); o.z = cvt_pk_bf16(v[4], v[5]); o.w = cvt_pk_bf16(v[6], v[7]);
        *(u32x4*)(ws + WS_LRUW + (size_t)idx * 16) = o;
    }
}

template <int MODE> __device__ __forceinline__ void norm_phase(const Ptrs& P, float* X, bf16_t* XN, const float* gain, int gw, int ngw, int lane) {
    f32x4 gv[8];
#pragma unroll
    for (int j = 0; j < 8; ++j) gv[j] = *(const f32x4*)(gain + 4 * (lane + 64 * j));
    for (int m = gw; m < T; m += ngw) {
        const float* src = (MODE == 1) ? (m < 8192 ? P.x_prompt() + (size_t)m * D : P.x_sample() + (size_t)(m - 8192) * D) : X + (size_t)m * D;
        f32x4 v[8]; float s = 0.f;
#pragma unroll
        for (int j = 0; j < 8; ++j) { v[j] = *(const f32x4*)(src + 4 * (lane + 64 * j)); s += (v[j][0] * v[j][0] + v[j][1] * v[j][1]) + (v[j][2] * v[j][2] + v[j][3] * v[j][3]); }
        const float rstd = 1.0f / sqrtf(wave_sum(s) * (1.0f / D) + EPS);
#pragma unroll
        for (int j = 0; j < 8; ++j) {
            if (MODE == 1) *(f32x4*)(X + (size_t)m * D + 4 * (lane + 64 * j)) = v[j];
            const f32x4 y = v[j] * rstd * gv[j];
            if (MODE == 2) *(f32x4*)(X + (size_t)m * D + 4 * (lane + 64 * j)) = y;
            else { u32x2 o; o.x = cvt_pk_bf16(y[0], y[1]); o.y = cvt_pk_bf16(y[2], y[3]); *(u32x2*)(XN + (size_t)m * D + 4 * (lane + 64 * j)) = o; }
        }
    }
}

__device__ __forceinline__ bool seq_start(int m) { return m == 0 || (m >= 8192 && (m & 4095) == 0); }
__device__ __forceinline__ int seq_lo(int m) { return m < 8192 ? 0 : (m & ~4095); }
__device__ __forceinline__ int seq_hi(int m) { return m < 8192 ? 8192 : (m & ~4095) + 4096; }

constexpr int XC_LD = 68, XCB_LD = 72;
template <int PASS> __device__ __forceinline__ void lru_unit(const Ptrs& P, unsigned char* ws, int l, int tc, int hb, unsigned char* lds, int tid) {
    float* XC = (float*)lds;
    bf16_t* XCB = (bf16_t*)(lds + 128 * XC_LD * 4);
    float* HF = (float*)(lds + 128 * XC_LD * 4 + 128 * XCB_LD * 2);
    float* HB = HF + 128 * XC_LD;
    const bf16_t* XR = (const bf16_t*)(ws + WS_R + R_XR);
    const int t0 = tc * LT, ch0 = hb * 64, lo = seq_lo(t0), hi = seq_hi(t0);
    const int lane = tid & 63, wid = tid >> 6;
    {
        const float* cwp = P.lru_conv_w() + (size_t)l * 4 * 1024; const float* cbp = P.lru_conv_b() + (size_t)l * 1024;
#pragma unroll
        for (int it = 0; it < 2; ++it) {
            const int pc = tid + it * 512, r = pc >> 3, c8 = (pc & 7) * 8, tok = t0 + r, ch = ch0 + c8;
            float a[8];
#pragma unroll
            for (int e = 0; e < 8; ++e) a[e] = cbp[ch + e];
#pragma unroll
            for (int k = 0; k < 4; ++k) { const int ts = tok + k - 2;
                if (ts >= lo && ts < hi) { const u32x4 xv = *(const u32x4*)(XR + (size_t)ts * 1024 + ch); f32x4 x0, x1; pg8::unpack8(xv, x0, x1);
                    const f32x4 w0 = *(const f32x4*)(cwp + k * 1024 + ch), w1 = *(const f32x4*)(cwp + k * 1024 + ch + 4);
#pragma unroll
                    for (int e = 0; e < 4; ++e) { a[e] += w0[e] * x0[e]; a[4 + e] += w1[e] * x1[e]; } } }
#pragma unroll
            for (int e = 0; e < 8; ++e) XC[r * XC_LD + c8 + e] = a[e];
            u32x4 o; o.x = cvt_pk_bf16(a[0], a[1]); o.y = cvt_pk_bf16(a[2], a[3]); o.z = cvt_pk_bf16(a[4], a[5]); o.w = cvt_pk_bf16(a[6], a[7]);
            *(u32x4*)(XCB + r * XCB_LD + c8) = o;
        }
    }
    __syncthreads();
    const int d = wid >> 2, cs = wid & 3, q = lane >> 4, chl = cs * 16 + (lane & 15), ch = ch0 + chl;
    f32x4 accr[8], accg[8];
    {
        const bf16x8* wf = (const bf16x8*)(ws + WS_LRUW + ((size_t)((l * 16 + hb) * 8 + wid) * 4) * 1024) + lane;
        const bf16x8 ba0 = wf[0], ba1 = wf[64], bx0 = wf[128], bx1 = wf[192];
#pragma unroll
        for (int mt = 0; mt < 8; ++mt) {
            const bf16x8 a0 = *(const bf16x8*)(XCB + (mt * 16 + (lane & 15)) * XCB_LD + 8 * q), a1 = *(const bf16x8*)(XCB + (mt * 16 + (lane & 15)) * XCB_LD + 32 + 8 * q);
            f32x4 z = (f32x4){0.f, 0.f, 0.f, 0.f};
            accr[mt] = __builtin_amdgcn_mfma_f32_16x16x32_bf16(a0, ba0, z, 0, 0, 0); accr[mt] = __builtin_amdgcn_mfma_f32_16x16x32_bf16(a1, ba1, accr[mt], 0, 0, 0);
            accg[mt] = __builtin_amdgcn_mfma_f32_16x16x32_bf16(a0, bx0, z, 0, 0, 0); accg[mt] = __builtin_amdgcn_mfma_f32_16x16x32_bf16(a1, bx1, accg[mt], 0, 0, 0);
        }
    }
    const float b_a = P.lru_b_a()[(size_t)(l * 2 + d) * 1024 + ch], b_x = P.lru_b_x()[(size_t)(l * 2 + d) * 1024 + ch], lam = P.lru_lambda()[(size_t)(l * 2 + d) * 1024 + ch];
    const float c8v = -8.0f * (lam > 15.f ? expf(-lam) : log1pf(expf(-lam)));
#pragma unroll
    for (int mt = 0; mt < 8; ++mt)
#pragma unroll
        for (int rg = 0; rg < 4; ++rg) {
            const float xcv = XC[(mt * 16 + 4 * q + rg) * XC_LD + chl];
            const float r = fast_sigmoid(accr[mt][rg] + b_a), gi = fast_sigmoid(accg[mt][rg] + b_x);
            const float la = c8v * r, a = __expf(la), bm = sqrtf(-expm1f(2.0f * la));
            accr[mt][rg] = a; accg[mt][rg] = bm * gi * xcv;
        }
    const int qq = d ? 3 - q : q;
    const int src1 = d ? lane + 16 : lane - 16, src2 = d ? lane + 32 : lane - 32, srcl = d ? (lane & 15) : (lane & 15) + 48;
    float Ai[8], Bi[8], Ae[8], Be[8];
#pragma unroll
    for (int mt = 0; mt < 8; ++mt) {
        float A, B;
        if (d == 0) { A = accr[mt][0]; B = accg[mt][0];
#pragma unroll
            for (int rg = 1; rg < 4; ++rg) { B = B * accr[mt][rg] + accg[mt][rg]; A *= accr[mt][rg]; } }
        else { A = accr[mt][3]; B = accg[mt][3];
#pragma unroll
            for (int rg = 2; rg >= 0; --rg) { B = B * accr[mt][rg] + accg[mt][rg]; A *= accr[mt][rg]; } }
        float Ap = __shfl(A, src1), Bp = __shfl(B, src1);
        if (qq >= 1) { B = Bp * A + B; A = Ap * A; }
        Ap = __shfl(A, src2); Bp = __shfl(B, src2);
        if (qq >= 2) { B = Bp * A + B; A = Ap * A; }
        Ai[mt] = A; Bi[mt] = B;
        Ap = __shfl(A, src1); Bp = __shfl(B, src1);
        Ae[mt] = qq >= 1 ? Ap : 1.0f; Be[mt] = qq >= 1 ? Bp : 0.0f;
    }
    if (PASS == 1) {
        float A = 1.0f, B = 0.0f;
#pragma unroll
        for (int s = 0; s < 8; ++s) { const int mt = d ? 7 - s : s; const float At = __shfl(Ai[mt], srcl), Bt = __shfl(Bi[mt], srcl); B = B * At + Bt; A *= At; }
        if (q == 0) { float* o = (float*)(ws + WS_R + R_LSUM) + ((size_t)(d * NTC + tc) * 1024 + ch) * 2; o[0] = A; o[1] = B; }
    } else {
        float carry = ((const float*)(ws + WS_R + R_CIN))[(size_t)(d * NTC + tc) * 1024 + ch];
        float* Hout = d ? HB : HF;
#pragma unroll
        for (int s = 0; s < 8; ++s) { const int mt = d ? 7 - s : s;
            const float At = __shfl(Ai[mt], srcl), Bt = __shfl(Bi[mt], srcl);
            float h = Ae[mt] * carry + Be[mt];
            if (d == 0) {
#pragma unroll
                for (int rg = 0; rg < 4; ++rg) { h = accr[mt][rg] * h + accg[mt][rg]; Hout[(mt * 16 + 4 * q + rg) * XC_LD + chl] = h; } }
            else {
#pragma unroll
                for (int rg = 3; rg >= 0; --rg) { h = accr[mt][rg] * h + accg[mt][rg]; Hout[(mt * 16 + 4 * q + rg) * XC_LD + chl] = h; } }
            carry = At * carry + Bt;
        }
        __syncthreads();
        const bf16_t* GG = (const bf16_t*)(ws + WS_R + R_GG); bf16_t* YB = (bf16_t*)(ws + WS_R + R_YB);
#pragma unroll
        for (int it = 0; it < 2; ++it) {
            const int pc = tid + it * 512, r = pc >> 3, c8 = (pc & 7) * 8; const size_t go = (size_t)(t0 + r) * 1024 + ch0 + c8;
            f32x4 g0, g1; pg8::unpack8(*(const u32x4*)(GG + go), g0, g1);
            f32x4 y0, y1;
#pragma unroll
            for (int e = 0; e < 4; ++e) { y0[e] = (HF[r * XC_LD + c8 + e] + HB[r * XC_LD + c8 + e]) * g0[e]; y1[e] = (HF[r * XC_LD + c8 + 4 + e] + HB[r * XC_LD + c8 + 4 + e]) * g1[e]; }
            *(u32x4*)(YB + go) = pg8::pack8(y0, y1);
        }
    }
    __syncthreads();
}

__device__ __forceinline__ void scan_phase(const Ptrs& P, unsigned char* ws, int l, int gt) {
    if (gt < 5 * SG * 2 * SP) {
        const int p = gt & 63, d = (gt >> 6) & 1, g = (gt >> 7) & 63, sq = gt >> 13;
        const int c_lo = sq == 0 ? 0 : 256 + 128 * (sq - 1), n = sq == 0 ? 256 : 128;
        const size_t o = ((size_t)(l * 2 + d) * SG + g) * SP + p;
        const float dt = expf(P.s5_log_dt()[(l * 2 + d) * SG + g]);
        const float x = P.s5_a_re()[o] * dt * 32.0f, y = P.s5_a_im()[o] * dt * 32.0f;
        const float e = expf(x); float sn, cs; sincosf(y, &sn, &cs);
        const float ar = e * cs, ai = e * sn;
        const float* Sb = (const float*)(ws + WS_R + R_SBUF) + (size_t)g * NCR * 256 + d * 128 + p;
        bf16_t* Hb = (bf16_t*)(ws + WS_R + R_UH) + (size_t)g * NCR * UHW + 512 + d * 128 + p;
        float hr = 0.f, hi = 0.f;
        for (int c0 = 0; c0 < n; c0 += 8) {
            float sr[8], si[8];
#pragma unroll
            for (int j = 0; j < 8; ++j) { const int cr = d ? c_lo + n - 1 - (c0 + j) : c_lo + c0 + j; sr[j] = Sb[(size_t)cr * 256]; si[j] = Sb[(size_t)cr * 256 + 64]; }
#pragma unroll
            for (int j = 0; j < 8; ++j) { const int cr = d ? c_lo + n - 1 - (c0 + j) : c_lo + c0 + j;
                Hb[(size_t)cr * UHW] = (bf16_t)(cvt_pk_bf16(hr, 0.f) & 0xffffu); Hb[(size_t)cr * UHW + 64] = (bf16_t)(cvt_pk_bf16(hi, 0.f) & 0xffffu);
                const float nr = ar * hr - ai * hi + sr[j], ni = ar * hi + ai * hr + si[j]; hr = nr; hi = ni; }
        }
    } else if (gt < 5 * SG * 2 * SP + 5 * 2 * 1024) {
        const int t = gt - 5 * SG * 2 * SP, ch = t & 1023, d = (t >> 10) & 1, sq = t >> 11;
        const int c_lo = sq == 0 ? 0 : 64 + 32 * (sq - 1), n = sq == 0 ? 64 : 32;
        const float* Ls = (const float*)(ws + WS_R + R_LSUM) + ((size_t)d * NTC * 1024 + ch) * 2;
        float* Ci = (float*)(ws + WS_R + R_CIN) + (size_t)d * NTC * 1024 + ch;
        float carry = 0.f;
        for (int c0 = 0; c0 < n; c0 += 8) {
            f32x2 ab[8];
#pragma unroll
            for (int j = 0; j < 8; ++j) { const int tc = d ? c_lo + n - 1 - (c0 + j) : c_lo + c0 + j; ab[j] = *(const f32x2*)(Ls + (size_t)tc * 2048); }
#pragma unroll
            for (int j = 0; j < 8; ++j) { const int tc = d ? c_lo + n - 1 - (c0 + j) : c_lo + c0 + j; Ci[(size_t)tc * 1024] = carry; carry = ab[j][0] * carry + ab[j][1]; }
        }
    }
}

__device__ __forceinline__ void fix_phase(const Ptrs& P, unsigned char* ws, int l, int gt, int ngt) {
    const float* EDGE = (const float*)(ws + WS_R + R_EDGE); bf16_t* ACT = (bf16_t*)(ws + WS_R + R_ACT); const float* cw = P.ffn_conv_w() + (size_t)l * 3 * F2;
    const int total = 95 * 2 * (FH / 4);
    for (int idx = gt; idx < total; idx += ngt) {
        const int c4 = (idx % (FH / 4)) * 4, rb = idx / (FH / 4), which = rb & 1, b = (rb >> 1) + 1, row = b * 256;
        if (seq_start(row)) continue;
        const float* e0 = which ? EDGE + ((size_t)(b - 1) * 4 + 3) * 2 * FH : EDGE + ((size_t)(b - 1) * 4 + 2) * 2 * FH;
        const float* e1 = which ? EDGE + ((size_t)b * 4 + 0) * 2 * FH : EDGE + ((size_t)(b - 1) * 4 + 3) * 2 * FH;
        const float* e2 = which ? EDGE + ((size_t)b * 4 + 1) * 2 * FH : EDGE + ((size_t)b * 4 + 0) * 2 * FH;
        f32x4 hg, hv;
        {
            const f32x4 p = *(const f32x4*)(e0 + c4), c = *(const f32x4*)(e1 + c4), n = *(const f32x4*)(e2 + c4);
            hg = *(const f32x4*)(cw + c4) * p + *(const f32x4*)(cw + F2 + c4) * c + *(const f32x4*)(cw + 2 * F2 + c4) * n;
            const f32x4 pv = *(const f32x4*)(e0 + FH + c4), cv = *(const f32x4*)(e1 + FH + c4), nv = *(const f32x4*)(e2 + FH + c4);
            hv = *(const f32x4*)(cw + FH + c4) * pv + *(const f32x4*)(cw + F2 + FH + c4) * cv + *(const f32x4*)(cw + 2 * F2 + FH + c4) * nv;
        }
        u32x2 o; o.x = cvt_pk_bf16(gelu_tanh(hg[0]) * hv[0], gelu_tanh(hg[1]) * hv[1]); o.y = cvt_pk_bf16(gelu_tanh(hg[2]) * hv[2], gelu_tanh(hg[3]) * hv[3]);
        *(u32x2*)(ACT + (size_t)(which ? row : row - 1) * FH + c4) = o;
    }
}

__global__ void __launch_bounds__(512, 2) fwd(Args args) {
    extern __shared__ __attribute__((aligned(16))) unsigned char lds[];
    const int tid = threadIdx.x;
    const int G = gridDim.x, bx = blockIdx.x;
    const int ngw = G * 8, ngt = G * 512;
#define WAVE_OF(td) __builtin_amdgcn_readfirstlane((td) >> 6)
    unsigned char* ws = args.ws;
    Ptrs P; P.a = &args;
    float* X = args.out;
    LAS unsigned char* ldsl = (LAS unsigned char*)lds;
    volatile LAS unsigned* MISC = (volatile LAS unsigned*)(ldsl + MISC_OFF);
    if (tid < 64) MISC[tid] = 0u;
    __syncthreads();
    const int lo = args.ph_lo, hi = args.ph_hi;
    XcdBarrier bar; bar.bar = (unsigned*)(ws + WS_CTL) + CW_BAR; bar.x = 0; bar.st = MISC + 8;
    if (hi - lo > 1) bar = xcd_barrier_post((unsigned*)(ws + WS_CTL) + CW_BAR, MISC + 8);
#ifndef PH_MASK
#define PH_MASK 0xFFFF
#endif
#define EN(k) (((PH_MASK) >> (k)) & 1)
#define RUN(p) (lo <= (p) && (p) < hi)
#define SEAM(p) do { if (RUN(p) && RUN((p) + 1)) xcd_barrier(bar); } while (0)

    bf16_t* XN = (bf16_t*)(ws + WS_XN);
    bf16_t* UH = (bf16_t*)(ws + WS_R + R_UH); bf16_t* XR = (bf16_t*)(ws + WS_R + R_XR); bf16_t* TMP = (bf16_t*)(ws + WS_R + R_TMP); bf16_t* GG = (bf16_t*)(ws + WS_R + R_GG);
    bf16_t* SGA = (bf16_t*)(ws + WS_R + R_SGA); bf16_t* SGB = (bf16_t*)(ws + WS_R + R_SGB); float* SBUF = (float*)(ws + WS_R + R_SBUF); bf16_t* YA = (bf16_t*)(ws + WS_R + R_YA);
    bf16_t* YG = (bf16_t*)(ws + WS_R + R_YG); bf16_t* YB = (bf16_t*)(ws + WS_R + R_YB); bf16_t* ACT = (bf16_t*)(ws + WS_R + R_ACT); float* EDGE = (float*)(ws + WS_R + R_EDGE);

    if (EN(0) && RUN(0)) {
        const int td = opaque(tid), lane = td & 63, wave = WAVE_OF(td), gw = bx * 8 + wave, gt = bx * 512 + td;
        for (int it = bx; it < DEPTH * SG; it += G) s5_prep_item(P, ws, it / SG, it % SG, (float*)lds, td);
        lru_prep(P, ws, gt, ngt);
        float* scr = (float*)(lds + wave * 16384);
        transpose_all(P.w_in(), D, INC, ws, WL_IN, false, scr, lane, gw, ngw);
        transpose_all(P.s5_w_glu(), 1024, 1024, ws, WL_GLU, false, scr, lane, gw, ngw);
        transpose_all(P.w_proj_a(), 1024, D, ws, WL_PA, false, scr, lane, gw, ngw);
        transpose_all(P.w_proj_b(), 1024, D, ws, WL_PB, false, scr, lane, gw, ngw);
        transpose_all(P.w_out(), D, D, ws, WL_OUT, false, scr, lane, gw, ngw);
        transpose_all(P.ffn_w_up(), D, F2, ws, WL_UP, true, scr, lane, gw, ngw);
        transpose_all(P.ffn_w_down(), FH, D, ws, WL_DOWN, false, scr, lane, gw, ngw);
        __syncthreads();
    }
    SEAM(0);

#pragma unroll 1
    for (int l = 0; l < DEPTH; ++l) {
        const int pb = 1 + l * NPH_LAYER;
        unsigned char* wl = ws + WS_W + (size_t)l * WL_STRIDE;
        if (EN(1) && RUN(pb + 0)) { const int td = opaque(tid), ln = td & 63, gw = bx * 8 + WAVE_OF(td); if (l == 0) norm_phase<1>(P, X, XN, P.norm1_g(), gw, ngw, ln); else norm_phase<0>(P, X, XN, P.norm1_g() + (size_t)l * D, gw, ngw, ln); }
        SEAM(pb + 0);
        if (EN(2) && RUN(pb + 1)) {
            pg8::Gemm g{XN, (const bf16_t*)(wl + WL_IN), D, D, D}; pg8::OrderMN S; S.init(T, INC, G, bx);
            pg8::EpiIn E{UH, XR, GG, SGA, SGB};
            pg8::gemm_phase(ldsl, g, S, E);
        }
        SEAM(pb + 1);
        if (EN(3) && RUN(pb + 2)) {
#ifndef NO_SG
            { pg8::Gemm g{UH, (const bf16_t*)(ws + WS_S5 + (size_t)l * S5_STRIDE + S5_BT1), UHW, 512, 512}; pg8::OrderBatched<3, 1, NCR, 256, SG> S; S.init(G, bx);
              pg8::EpiS1 E{SBUF}; pg8::gemm_phase(ldsl, g, S, E); }
#endif
#ifndef NO_LRU
            { const int td = opaque(tid); for (int u = bx; u < NTC * 16; u += G) lru_unit<1>(P, ws, l, u >> 4, u & 15, lds, td); }
#endif
        }
        SEAM(pb + 2);
        if (EN(4) && RUN(pb + 3)) scan_phase(P, ws, l, bx * 512 + opaque(tid));
        SEAM(pb + 3);
        if (EN(5) && RUN(pb + 4)) {
#ifndef NO_SG
            { pg8::Gemm g{UH, (const bf16_t*)(ws + WS_S5 + (size_t)l * S5_STRIDE + S5_BT2), UHW, UHW, UHW}; pg8::OrderBatched<3, 2, NCR, 512, SG> S; S.init(G, bx);
              pg8::EpiS2 E{YG}; pg8::gemm_phase(ldsl, g, S, E); }
#endif
#ifndef NO_LRU
            { const int td = opaque(tid); for (int u = bx; u < NTC * 16; u += G) lru_unit<2>(P, ws, l, u >> 4, u & 15, lds, td); }
#endif
        }
        SEAM(pb + 4);
        if (EN(6) && RUN(pb + 5)) {
            { pg8::Gemm g{YG, (const bf16_t*)(wl + WL_GLU), 1024, 1024, 1024}; pg8::OrderMN S; S.init(T, 1024, G, bx); pg8::EpiMul<0> E{YA, YG, 1024}; pg8::gemm_phase(ldsl, g, S, E); }
            { pg8::Gemm g{YB, (const bf16_t*)(wl + WL_PB), 1024, 1024, 1024}; pg8::OrderMN S; S.init(T, D, G, bx); pg8::EpiMul<1> E{TMP, SGB, D}; pg8::gemm_phase(ldsl, g, S, E); }
        }
        SEAM(pb + 5);
        if (EN(7) && RUN(pb + 6)) { pg8::Gemm g{YA, (const bf16_t*)(wl + WL_PA), 1024, 1024, 1024}; pg8::OrderMN S; S.init(T, D, G, bx); pg8::EpiMul<2> E{TMP, SGA, D}; pg8::gemm_phase(ldsl, g, S, E); }
        SEAM(pb + 6);
        if (EN(8) && RUN(pb + 7)) { pg8::Gemm g{TMP, (const bf16_t*)(wl + WL_OUT), D, D, D}; pg8::OrderMN S; S.init(T, D, G, bx); pg8::EpiRes E{X}; pg8::gemm_phase(ldsl, g, S, E); }
        SEAM(pb + 7);
        if (EN(9) && RUN(pb + 8)) { const int td = opaque(tid); norm_phase<0>(P, X, XN, P.norm2_g() + (size_t)l * D, bx * 8 + WAVE_OF(td), ngw, td & 63); }
        SEAM(pb + 8);
        if (EN(10) && RUN(pb + 9)) {
            pg8::Gemm g{XN, (const bf16_t*)(wl + WL_UP), D, D, D}; pg8::OrderMN S; S.init(T, F2, G, bx);
            pg8::EpiUp E{ACT, EDGE, P.ffn_conv_w() + (size_t)l * 3 * F2, (LAS float*)(ldsl + XCH_OFF)};
            pg8::gemm_phase(ldsl, g, S, E);
        }
        SEAM(pb + 9);
        if (EN(11) && RUN(pb + 10)) fix_phase(P, ws, l, bx * 512 + opaque(tid), ngt);
        SEAM(pb + 10);
        if (EN(12) && RUN(pb + 11)) { pg8::Gemm g{ACT, (const bf16_t*)(wl + WL_DOWN), FH, FH, FH}; pg8::OrderMN S; S.init(T, D, G, bx); pg8::EpiRes E{X}; pg8::gemm_phase(ldsl, g, S, E); }
        SEAM(pb + 11);
    }
    if (EN(13) && RUN(NPHASE - 1)) { const int td = opaque(tid); norm_phase<2>(P, X, XN, P.final_g(), bx * 8 + WAVE_OF(td), ngw, td & 63); }
#undef RUN
#undef SEAM
}

extern "C" void kernel_launch(void* const* d_in, const int* in_sizes, int n_in, void* d_out, int out_size, void* d_ws, size_t ws_size, hipStream_t stream) {
    static int grid = 0;
    if (grid == 0) {
        if (n_in != 28 || out_size != T * D || ws_size < WS_END) { fprintf(stderr, "kernel_launch: unexpected shapes: n_in %d out %d ws %zu (need %zu)\n", n_in, out_size, ws_size, (size_t)WS_END); grid = -1; return; }
        int dev = 0, cus = 0, per_cu = 0;
        if (hipGetDevice(&dev) != hipSuccess || hipDeviceGetAttribute(&cus, hipDeviceAttributeMultiprocessorCount, dev) != hipSuccess) { grid = -1; return; }
        if (hipFuncSetAttribute((const void*)fwd, hipFuncAttributeMaxDynamicSharedMemorySize, LDS_BYTES) != hipSuccess) { fprintf(stderr, "kernel_launch: hipFuncSetAttribute failed\n"); grid = -1; return; }
        if (hipOccupancyMaxActiveBlocksPerMultiprocessor(&per_cu, (const void*)fwd, 512, LDS_BYTES) != hipSuccess || per_cu < 1) { fprintf(stderr, "kernel_launch: occupancy query says %d\n", per_cu); }
        (void)hipGetLastError();
        grid = cus;
    }
    if (grid < 0) return;
    (void)hipMemsetAsync((char*)d_ws + WS_CTL, 0, CTL_BYTES, stream);
    Args a{};
    for (int i = 0; i < 28; ++i) a.in[i] = (const float*)d_in[i];
    a.out = (float*)d_out; a.ws = (unsigned char*)d_ws;
#if MK_ONE_LAUNCH
    a.ph_lo = 0; a.ph_hi = NPHASE;
    hipLaunchKernelGGL(fwd, dim3(grid), dim3(512), LDS_BYTES, stream, a);
#else
    for (int p = 0; p < NPHASE; ++p) { a.ph_lo = p; a.ph_hi = p + 1; hipLaunchKernelGGL(fwd, dim3(grid), dim3(512), LDS_BYTES, stream, a); }
#endif
}
```

```cpp
#include <hip/hip_runtime.h>
#include <cstdio>
#include <cstdint>

#ifndef MK_ONE_LAUNCH
#define MK_ONE_LAUNCH 1
#endif

#define LAS __attribute__((address_space(3)))
#define GAS __attribute__((address_space(1)))
typedef unsigned short bf16_t;
typedef short bf16x8 __attribute__((ext_vector_type(8)));
typedef float f32x4 __attribute__((ext_vector_type(4)));
typedef float f32x2 __attribute__((ext_vector_type(2)));
typedef unsigned u32x4 __attribute__((ext_vector_type(4)));
typedef unsigned u32x2 __attribute__((ext_vector_type(2)));

constexpr int D = 2048, T = 24576, DEPTH = 4, INC = 7168, FH = 6144, F2 = 12288;
constexpr int SG = 64, SP = 64, SH = 16, SL = 32;
constexpr int NCR = T / SL;
constexpr int UHW = SL * SH + 4 * SP;
constexpr int LT = 128, NTC = T / LT;
constexpr float EPS = 1e-6f;
constexpr int IN_FULL_ROUNDS = (T / 256) * (7168 / 256) / 256;
constexpr int NPH_LAYER = 8, NPHASE = 2 + DEPTH * NPH_LAYER;

constexpr size_t MiB = 1u << 20;
constexpr size_t WS_CTL = 0, CTL_BYTES = 3 * MiB;
constexpr size_t WS_RSS = 1 * MiB;
constexpr size_t WS_W = 4 * MiB;
constexpr size_t WL_IN = 0, WL_GLU = 28 * MiB, WL_PA = 30 * MiB, WL_PB = 34 * MiB, WL_OUT = 38 * MiB, WL_UP = 46 * MiB, WL_DOWN = 94 * MiB, WL_STRIDE = 118 * MiB;
constexpr size_t WS_S5 = WS_W + DEPTH * WL_STRIDE;
constexpr size_t S5_BT1 = 0, S5_BT2 = 16 * MiB, S5_STRIDE = 64 * MiB;
constexpr size_t WS_LRUW = WS_S5 + DEPTH * S5_STRIDE;
constexpr size_t LRUW_STRIDE = 512 * 1024;
constexpr size_t WS_C8V = 3 * MiB - 64 * 1024;
constexpr size_t WS_XN = WS_LRUW + 2 * MiB;
constexpr size_t WS_R = WS_XN + 96 * MiB;
constexpr size_t R_UH = 0, R_XR = 72 * MiB, R_TMP = 0  , R_GG = 120 * MiB, R_SGA = 168 * MiB, R_SGB = 264 * MiB, R_SBUF = 360 * MiB, R_YA = 360 * MiB  ,
                 R_YG = 408 * MiB, R_YB = 456 * MiB, R_LSUM = 504 * MiB, R_CIN = 508 * MiB, R_MIX_END = 510 * MiB;
constexpr size_t R_ACT = 0, R_EDGE = 288 * MiB, R_FFN_END = 307 * MiB;
constexpr size_t WS_END = WS_R + R_MIX_END;
static_assert(WS_RSS + (size_t)9 * T * 8 <= WS_C8V && WS_C8V + DEPTH * 2 * 1024 * 4 <= CTL_BYTES && CTL_BYTES <= WS_W, "control region");
static_assert((size_t)SG * NCR * UHW * 2 == 72 * MiB && (size_t)T * 1024 * 2 == 48 * MiB && (size_t)SG * NCR * 256 * 4 == 48 * MiB, "sizes");
static_assert((size_t)96 * 4 * 2 * FH * 4 <= 19 * MiB && R_FFN_END <= R_MIX_END, "ffn overlay");

constexpr int CW_BAR = 4096, CW_LRUQ = 16384, CW_SCNT = 24576, CW_LCNT = 28672;
constexpr int CW_LRUQ_DOC = 0;

constexpr int STAGE_BYTES = 131072, XCH_OFF = 131072, XCH_BYTES = 8192, MISC_OFF = XCH_OFF + XCH_BYTES, SIDE_OFF = MISC_OFF + 1024, SIDE_BYTES = 6144, LDS_BYTES = 155648;
static_assert(SIDE_OFF + 2 * SIDE_BYTES <= LDS_BYTES && LDS_BYTES <= 163840, "LDS map");

typedef __bf16 bf16x2_t __attribute__((ext_vector_type(2)));
__device__ __forceinline__ unsigned cvt_pk_bf16(float lo, float hi) { const f32x2 v = {lo, hi}; return __builtin_bit_cast(unsigned, __builtin_convertvector(v, bf16x2_t)); }
__device__ __forceinline__ float bf_lo(unsigned w) { return __uint_as_float(w << 16); }
__device__ __forceinline__ float bf_hi(unsigned w) { return __uint_as_float(w & 0xffff0000u); }
__device__ __forceinline__ float fast_sigmoid(float x) { return __builtin_amdgcn_rcpf(1.0f + __builtin_amdgcn_exp2f(x * -1.44269504f)); }
__device__ __forceinline__ float gelu_tanh(float x) { const float t = x * (-2.3022082f + -0.10294324f * (x * x)); return x * __builtin_amdgcn_rcpf(1.0f + __builtin_amdgcn_exp2f(t)); }
typedef unsigned long long u64;
constexpr float RSS_SCALE = 16777216.0f, RSS_INV = 1.0f / 16777216.0f / (float)D;
__device__ __forceinline__ float rss_mean(u64 q) { return ((float)(unsigned)(q >> 32) * 4294967296.0f + (float)(unsigned)q) * RSS_INV; }
__device__ __forceinline__ void sigmoid8(f32x4& a, f32x4& b) {
    f32x4 ta = a * -1.44269504f, tb = b * -1.44269504f;
#pragma unroll
    for (int j = 0; j < 4; ++j) { ta[j] = __builtin_amdgcn_exp2f(ta[j]); tb[j] = __builtin_amdgcn_exp2f(tb[j]); }
    ta = ta + 1.0f; tb = tb + 1.0f;
#pragma unroll
    for (int j = 0; j < 4; ++j) { a[j] = __builtin_amdgcn_rcpf(ta[j]); b[j] = __builtin_amdgcn_rcpf(tb[j]); }
}
__device__ __forceinline__ void gelu8(f32x4& a, f32x4& b) {
    f32x4 ta = a * (a * a * -0.10294324f + -2.3022082f), tb = b * (b * b * -0.10294324f + -2.3022082f);
#pragma unroll
    for (int j = 0; j < 4; ++j) { ta[j] = __builtin_amdgcn_exp2f(ta[j]); tb[j] = __builtin_amdgcn_exp2f(tb[j]); }
    ta = ta + 1.0f; tb = tb + 1.0f;
#pragma unroll
    for (int j = 0; j < 4; ++j) { ta[j] = __builtin_amdgcn_rcpf(ta[j]); tb[j] = __builtin_amdgcn_rcpf(tb[j]); }
    a = a * ta; b = b * tb;
}
__device__ __forceinline__ float wave_sum(float v) {
#pragma unroll
    for (int o = 1; o < 64; o <<= 1) v += __shfl_xor(v, o);
    return v;
}
__device__ __forceinline__ int opaque(int v) { asm volatile("" : "+v"(v)); return v; }
__device__ __forceinline__ int tid_of(int wave_s) { unsigned z = 0u; asm volatile("" : "+s"(z)); return wave_s * 64 + (int)__builtin_amdgcn_mbcnt_hi(~0u, __builtin_amdgcn_mbcnt_lo(~0u, z)); }
template <class Tp> __device__ __forceinline__ Tp* launder(Tp* p) { unsigned lo = (unsigned)(uintptr_t)p, hi = (unsigned)((uintptr_t)p >> 32); asm volatile("" : "+v"(lo), "+v"(hi));
    lo = __builtin_amdgcn_readfirstlane(lo); hi = __builtin_amdgcn_readfirstlane(hi); return (Tp*)(((uintptr_t)hi << 32) | lo); }
template <int CTRL> __device__ __forceinline__ float dppf(float x) { return __builtin_bit_cast(float, __builtin_amdgcn_update_dpp(0, __builtin_bit_cast(int, x), CTRL, 0xf, 0xf, false)); }

#define XB_TMO      128
#define XB_XCNT(j)  (256  + 64 * (j))
#define XB_XSUB(j)  (1280 + 64 * (j))
#define XB_XGEN(j)  (2304 + 64 * (j))
#define XB_TOP      3328
#define XB_TOPGEN   3392
#define XCD_BAR_WORDS 3456
#define XB_SPIN_CAP (1u << 20)
__device__ __forceinline__ unsigned xb_ld(unsigned* p)              { return __hip_atomic_load(p, __ATOMIC_RELAXED, __HIP_MEMORY_SCOPE_AGENT); }
__device__ __forceinline__ unsigned xb_add(unsigned* p, unsigned v) { return __hip_atomic_fetch_add(p, v, __ATOMIC_RELAXED, __HIP_MEMORY_SCOPE_AGENT); }
__device__ __forceinline__ unsigned xb_xcc_id() { return (unsigned)__builtin_amdgcn_s_getreg((3 << 11) | 20) & 0xFu; }
#define XB_SPIN(cond, bar) do { unsigned _sp = 0; while (cond) { __builtin_amdgcn_s_sleep(1); \
    if ((++_sp & 255u) == 0u) { if (xb_ld(&(bar)[XB_TMO])) break; if (_sp > XB_SPIN_CAP) { atomicAdd(&(bar)[XB_TMO], 1u); break; } } } } while (0)
struct XcdBarrier { unsigned* bar; unsigned x; volatile LAS unsigned* st; };
__device__ __forceinline__ XcdBarrier xcd_barrier_post(unsigned* bar, volatile LAS unsigned* st) {
    XcdBarrier b; b.bar = bar; b.x = xb_xcc_id(); b.st = st;
    if (threadIdx.x == 0) (void)xb_add(&bar[XB_XCNT(b.x)], 1u);
    return b;
}
__device__ __forceinline__ void xcd_barrier_complete(unsigned* bar, unsigned x, unsigned& nloc, unsigned& nx) {
    const unsigned G = gridDim.x * gridDim.y * gridDim.z;
    unsigned sum, cnt, mine, sp = 0u;
    for (;;) {
        sum = 0u; cnt = 0u; mine = 0u;
#pragma unroll
        for (unsigned j = 0; j < 16; ++j) { const unsigned c = xb_ld(&bar[XB_XCNT(j)]); sum += c; cnt += (c > 0u) ? 1u : 0u; mine = (j == x) ? c : mine; }
        if (sum == G) break;
        __builtin_amdgcn_s_sleep(1);
        if ((++sp & 255u) == 0u) { if (xb_ld(&bar[XB_TMO])) break; if (sp > XB_SPIN_CAP) { atomicAdd(&bar[XB_TMO], 1u); break; } }
    }
    nloc = mine > 0u ? mine : 1u; nx = cnt > 0u ? cnt : 1u;
}
__device__ __forceinline__ void xcd_barrier(const XcdBarrier& b) {
    asm volatile("s_waitcnt vmcnt(0)" ::: "memory");
    __syncthreads();
    if (threadIdx.x == 0) {
        unsigned* bar = b.bar;
        __builtin_amdgcn_s_waitcnt(0);
        unsigned nloc = b.st[0], nx = b.st[1];
        if (nloc == 0u) { xcd_barrier_complete(bar, b.x, nloc, nx); b.st[0] = nloc; b.st[1] = nx; }
        const unsigned old = xb_add(&bar[XB_XSUB(b.x)], 1u);
        const unsigned gen = old / nloc;
        if (old + 1u == (gen + 1u) * nloc) {
            __builtin_amdgcn_fence(__ATOMIC_RELEASE, "agent");
            asm volatile("s_waitcnt vmcnt(0)" ::: "memory");
            const unsigned og = xb_add(&bar[XB_TOP], 1u);
            const unsigned tg = og / nx;
            if (og + 1u == (tg + 1u) * nx) xb_add(&bar[XB_TOPGEN], 1u);
            else XB_SPIN(xb_ld(&bar[XB_TOPGEN]) == tg, bar);
            __builtin_amdgcn_fence(__ATOMIC_ACQUIRE, "agent");
            xb_add(&bar[XB_XGEN(b.x)], 1u);
            asm volatile("s_waitcnt vmcnt(0)" ::: "memory");
        } else {
            XB_SPIN(xb_ld(&bar[XB_XGEN(b.x)]) == gen, bar);
            __builtin_amdgcn_fence(__ATOMIC_ACQUIRE, "agent");
            asm volatile("s_waitcnt vmcnt(0)" ::: "memory");
        }
    }
    __syncthreads();
}

namespace pg8 {
constexpr int BM = 256, BK = 64, HALF = 128, HTB = HALF * BK * 2, NXCD = 8, WGM = 8;
__host__ __device__ __forceinline__ int lds_byte(int r, int c) { const int st = (r >> 4) * 2 + (c >> 5), rr = r & 15, cc = c & 31, ob = rr * 64 + cc * 2; return st * 1024 + (ob ^ (((ob >> 9) & 1) << 5)); }
__host__ __device__ __forceinline__ void stage_rc(int b, int& R, int& C) { const int st = b / 1024, sb = b % 1024, swz = sb ^ (((sb >> 9) & 1) << 5); R = (st >> 1) * 16 + swz / 64; C = (st & 1) * 32 + (swz % 64) / 2; }
__host__ __device__ __forceinline__ int perm32(int rho) { const int n = rho >> 4, i = rho & 15; return 8 * (i >> 2) + 4 * n + (i & 3); }

struct Unit { int arow, brow, pm, pn, g; };
struct Gemm { const bf16_t* A; const bf16_t* Bt; int lda, ldb, K; };

struct OrderMN {
    int nM, nN, nwg, G, c, i0, iend;
    __device__ __forceinline__ void init(int M, int N, int G_, int c_) { nM = M / BM; nN = N / BM; nwg = nM * nN; G = G_; c = c_; i0 = 0; iend = 0x7fffffff; }
    __device__ __forceinline__ bool next(int i, Unit& u) const {
        i += i0; if (i >= iend) return false;
        const long L = (long)i * G + c; if (L >= nwg) return false;
        int wgid = (int)L; { const int q = nwg / NXCD, r = nwg % NXCD, xcd = wgid % NXCD, off = wgid / NXCD; wgid = (xcd < r ? xcd * (q + 1) : r * (q + 1) + (xcd - r) * q) + off; }
        const int nig = WGM * nN, gid = wgid / nig, fm = gid * WGM, gsz = (nM - fm) < WGM ? (nM - fm) : WGM;
        u.pm = fm + ((wgid % nig) % gsz); u.pn = (wgid % nig) / gsz; u.g = 0; u.arow = u.pm * BM; u.brow = u.pn * BM; return true;
    }
};
template <int NM, int NN, int AR, int BR, int NG> struct OrderBatched {
    int G, c;
    __device__ __forceinline__ void init(int G_, int c_) { G = G_; c = c_; }
    __device__ __forceinline__ bool next(int i, Unit& u) const {
        const int L = i * G + c; if (L >= NG * NM * NN) return false;
        const int g = L / (NM * NN), r = L % (NM * NN); u.g = g; u.pm = r % NM; u.pn = r / NM; u.arow = g * AR + u.pm * BM; u.brow = g * BR + u.pn * BM; return true;
    }
};

template <class Epi, class Sched>
__device__ __forceinline__ void gemm_phase(LAS unsigned char* lds, const Gemm g, const Sched& S, const Epi& E, int wave_s) {
    const int tid = tid_of(wave_s), wid = __builtin_amdgcn_readfirstlane(tid >> 6), lane = tid & 63, wr = wid >> 2, wc = wid & 3, fr = lane & 15, fq = lane >> 4;
    const int K = g.K, nt = K / BK;
    unsigned voffA[2], voffB[2];
#pragma unroll
    for (int i = 0; i < 2; ++i) { int R, C; stage_rc(tid * 16 + i * 8192, R, C); const int Rb = Epi::PERM ? ((R & ~31) + perm32(R & 31)) : R;
        voffA[i] = (unsigned)(R * g.lda + C) * 2u; voffB[i] = (unsigned)(Rb * g.ldb + C) * 2u; }
    const size_t kstep = (size_t)(BK * 2);
    const size_t hstepA = (size_t)HALF * g.lda * 2, hstepB = (size_t)HALF * g.ldb * 2;
    const size_t rstepA = (size_t)g.lda * 2, rstepB = (size_t)g.ldb * 2;
    const unsigned ldsw = (unsigned)wid * 1024u;
    const int aoff = lds_byte(wr * 64 + fr, fq * 8), boff = lds_byte(wc * 32 + fr, fq * 8);
#define PG8_SA(b, h) (((b) * 2 + (h)) * HTB)
#define PG8_SB(b, h) ((4 + (b) * 2 + (h)) * HTB)
    const unsigned ldsb = (unsigned)(unsigned long)lds + ldsw;
#define PG8_STAGE(bufoff, gbase, voff) do { unsigned keep_; \
        asm volatile("s_mov_b32 %0, m0\n\ts_mov_b32 m0, %3\n\ts_nop 0\n\tglobal_load_lds_dwordx4 %1, %5\n\ts_mov_b32 m0, %4\n\ts_nop 0\n\tglobal_load_lds_dwordx4 %2, %5\n\ts_mov_b32 m0, %0" \
            : "=&s"(keep_) : "v"((voff)[0]), "v"((voff)[1]), "s"(ldsb + (unsigned)(bufoff)), "s"(ldsb + (unsigned)(bufoff) + 8192u), "s"((const char*)(gbase)) : "memory"); } while (0)
#define PG8_LDA(dst, b, h) do { _Pragma("unroll") for (int m = 0; m < 4; ++m) _Pragma("unroll") for (int k = 0; k < 2; ++k) dst[m][k] = *(const LAS bf16x8*)(lds + PG8_SA(b, h) + aoff + m * 2048 + k * 1024); } while (0)
#define PG8_LDB(dst, b, h) do { _Pragma("unroll") for (int n = 0; n < 2; ++n) _Pragma("unroll") for (int k = 0; k < 2; ++k) dst[n][k] = *(const LAS bf16x8*)(lds + PG8_SB(b, h) + boff + n * 2048 + k * 1024); } while (0)
#define PG8_MMA(ai, bj, At, Bt) do { __builtin_amdgcn_s_setprio(1); _Pragma("unroll") for (int m = 0; m < 4; ++m) _Pragma("unroll") for (int n = 0; n < 2; ++n) _Pragma("unroll") for (int k = 0; k < 2; ++k) \
        acc[ai][bj][m][n] = __builtin_amdgcn_mfma_f32_16x16x32_bf16(Bt[n][k], At[m][k], acc[ai][bj][m][n], 0, 0, 0); __builtin_amdgcn_s_setprio(0); } while (0)
#define PG8_WAIT_V(n) asm volatile("s_waitcnt vmcnt(" #n ")" ::: "memory")
#define PG8_WAIT_L(n) asm volatile("s_waitcnt lgkmcnt(" #n ")" ::: "memory")
#define PG8_BAR __builtin_amdgcn_s_barrier()
#define PG8_SCHED __builtin_amdgcn_sched_barrier(0)
    Unit cur, nxt; int ui = 0;
    if (!S.next(0, cur)) return;
    f32x4 acc[2][2][4][2];
#pragma unroll
    for (int a = 0; a < 2; ++a)
#pragma unroll
        for (int b = 0; b < 2; ++b)
#pragma unroll
            for (int m = 0; m < 4; ++m)
#pragma unroll
                for (int n = 0; n < 2; ++n) acc[a][b][m][n] = (f32x4){0.f, 0.f, 0.f, 0.f};
    bf16x8 At[4][2], B0[2][2], B1[2][2];
    const char* cA = (const char*)g.A + (size_t)cur.arow * rstepA; const char* cB = (const char*)g.Bt + (size_t)cur.brow * rstepB;
    int par = 0;
    E.prefetch(cur, wid, lane, par);
    PG8_STAGE(PG8_SB(0, 0), cB, voffB); PG8_STAGE(PG8_SB(0, 1), cB + hstepB, voffB); PG8_STAGE(PG8_SA(0, 0), cA, voffA); PG8_STAGE(PG8_SA(0, 1), cA + hstepA, voffA);
    if (wr == 1) PG8_BAR;
    PG8_WAIT_V(2); PG8_BAR;
    PG8_STAGE(PG8_SB(1, 0), cB + kstep, voffB); PG8_STAGE(PG8_SA(1, 0), cA + kstep, voffA); PG8_STAGE(PG8_SB(1, 1), cB + hstepB + kstep, voffB);
    PG8_WAIT_V(6); PG8_BAR;
    for (;;) {
        const bool has_next = S.next(ui + 1, nxt);
        const char* nA = has_next ? (const char*)g.A + (size_t)nxt.arow * rstepA : cA; const char* nB = has_next ? (const char*)g.Bt + (size_t)nxt.brow * rstepB : cB;
        for (int t = 0; t < nt; t += 2) {
            const bool last = (t == nt - 2);
            const char* a1 = cA + (size_t)(t + 1) * kstep;
            const char* a2 = last ? nA : cA + (size_t)(t + 2) * kstep; const char* b2 = last ? nB : cB + (size_t)(t + 2) * kstep;
            const char* a3 = a2 + kstep; const char* b3 = b2 + kstep;
            PG8_LDB(B0, 0, 0); PG8_LDB(B1, 0, 1); PG8_SCHED; PG8_LDA(At, 0, 0); PG8_STAGE(PG8_SA(1, 1), a1 + hstepA, voffA);
            PG8_WAIT_V(8); PG8_WAIT_L(0); PG8_BAR; PG8_MMA(0, 0, At, B0); PG8_MMA(0, 1, At, B1); PG8_BAR; PG8_SCHED;
            PG8_LDA(At, 0, 1); PG8_STAGE(PG8_SB(0, 0), b2, voffB); PG8_STAGE(PG8_SB(0, 1), b2 + hstepB, voffB); PG8_STAGE(PG8_SA(0, 0), a2, voffA);
            PG8_WAIT_V(8); PG8_WAIT_L(0); PG8_BAR; PG8_MMA(1, 0, At, B0); PG8_MMA(1, 1, At, B1); PG8_BAR; PG8_SCHED;
            PG8_LDB(B0, 1, 0); PG8_LDB(B1, 1, 1); PG8_SCHED; PG8_LDA(At, 1, 0); PG8_STAGE(PG8_SA(0, 1), a2 + hstepA, voffA);
            PG8_WAIT_V(8); PG8_WAIT_L(0); PG8_BAR; PG8_MMA(0, 0, At, B0); PG8_MMA(0, 1, At, B1); PG8_BAR; PG8_SCHED;
            PG8_LDA(At, 1, 1); PG8_STAGE(PG8_SB(1, 0), b3, voffB); PG8_STAGE(PG8_SB(1, 1), b3 + hstepB, voffB); PG8_STAGE(PG8_SA(1, 0), a3, voffA);
            PG8_WAIT_V(8); PG8_WAIT_L(0); PG8_BAR; PG8_MMA(1, 0, At, B0); PG8_MMA(1, 1, At, B1); PG8_BAR; PG8_SCHED;
        }
        if (wr == 0) PG8_BAR;
        { unsigned z = 0u; asm volatile("" : "+s"(z)); const int ln = (int)__builtin_amdgcn_mbcnt_hi(~0u, __builtin_amdgcn_mbcnt_lo(~0u, z)); int wr_e = wr, wc_e = wc; asm volatile("" : "+s"(wr_e), "+s"(wc_e)); E(acc, cur, wr_e, wc_e, ln & 15, ln >> 4, par);
#ifdef PROBE_EPI2
          if (Epi::PROBE_ID == PROBE_EPI2) E(acc, cur, wr_e, wc_e, ln & 15, ln >> 4, par | 2);
#endif
          if (has_next) E.prefetch(nxt, wr_e * 4 + wc_e, ln, par ^ 1); }
        par ^= 1;
        if (!has_next) break;
#pragma unroll
        for (int a = 0; a < 2; ++a)
#pragma unroll
            for (int b = 0; b < 2; ++b)
#pragma unroll
                for (int m = 0; m < 4; ++m)
#pragma unroll
                    for (int n = 0; n < 2; ++n) acc[a][b][m][n] = (f32x4){0.f, 0.f, 0.f, 0.f};
        cur = nxt; cA = nA; cB = nB; ++ui;
        if (wr == 1) PG8_BAR;
    }
    PG8_WAIT_V(0);
    PG8_BAR;
#undef PG8_SA
#undef PG8_SB
#undef PG8_STAGE
#undef PG8_LDA
#undef PG8_LDB
#undef PG8_MMA
#undef PG8_WAIT_V
#undef PG8_WAIT_L
#undef PG8_BAR
#undef PG8_SCHED
}

typedef f32x4 Acc[2][2][4][2];
__device__ __forceinline__ u32x4 pack8(const f32x4 a, const f32x4 b) { u32x4 w; w.x = cvt_pk_bf16(a[0], a[1]); w.y = cvt_pk_bf16(a[2], a[3]); w.z = cvt_pk_bf16(b[0], b[1]); w.w = cvt_pk_bf16(b[2], b[3]); return w; }
__device__ __forceinline__ void unpack8(const u32x4 w, f32x4& a, f32x4& b) { a = (f32x4){bf_lo(w.x), bf_hi(w.x), bf_lo(w.y), bf_hi(w.y)}; b = (f32x4){bf_lo(w.z), bf_hi(w.z), bf_lo(w.w), bf_hi(w.w)}; }

struct EpiIn {
    static constexpr int PROBE_ID = 1;
    static constexpr bool PERM = true;
    bf16_t *UH, *XR, *GG, *SGA, *SGB; const u64* RS; LAS unsigned char* side;
    __device__ __forceinline__ void prefetch(const Unit& u, int wid, int lane, int par) const {
        if (wid < 2) __builtin_amdgcn_global_load_lds((const unsigned*)(RS + u.pm * BM + wid * 128 + lane * 2), (LAS unsigned*)(side + par * SIDE_BYTES + wid * 1024), 16, 0, 0);
    }
    template <int KIND> __device__ __forceinline__ void body(Acc& acc, const float (&rs)[2][4], int row0, int cb, bf16_t* base, int ld, int coff) const {
#pragma unroll
        for (int ai = 0; ai < 2; ++ai)
#pragma unroll
            for (int m = 0; m < 4; ++m) { const int r = row0 + ai * HALF + m * 16;
#pragma unroll
                for (int bj = 0; bj < 2; ++bj) { f32x4 v0 = acc[ai][bj][m][0] * rs[ai][m], v1 = acc[ai][bj][m][1] * rs[ai][m];
                    if (KIND == 2) gelu8(v0, v1); else if (KIND == 3) sigmoid8(v0, v1);
                    const u32x4 w = pack8(v0, v1);
                    if (KIND == 0) { const int c = cb + bj * HALF, gg = c >> 4; *(u32x4*)(UH + ((size_t)(gg * NCR + (r >> 5)) * UHW + (r & 31) * 16 + (c & 15))) = w; }
                    else *(u32x4*)(base + (size_t)r * ld + coff + bj * HALF) = w; } }
    }
    __device__ __forceinline__ void operator()(Acc& acc, const Unit& u, int wr, int wc, int fr, int fq, int par) const {
        par &= 1;
        const int pn = u.pn, row0 = u.pm * BM + wr * 64 + fr, cb = pn * BM + wc * 32 + 8 * fq;
        float rs[2][4];
#pragma unroll
        for (int ai = 0; ai < 2; ++ai)
#pragma unroll
            for (int m = 0; m < 4; ++m) rs[ai][m] = __builtin_amdgcn_rsqf(rss_mean(*(const LAS u64*)(side + par * SIDE_BYTES + (wr * 64 + fr + ai * HALF + m * 16) * 8)) + EPS);
        if (pn < 4) body<0>(acc, rs, row0, cb, UH, 0, 0);
        else if (pn < 8) body<1>(acc, rs, row0, cb, XR, 1024, cb - 1024);
        else if (pn < 12) body<2>(acc, rs, row0, cb, GG, 1024, cb - 2048);
        else if (pn < 20) body<3>(acc, rs, row0, cb, SGA, 2048, cb - 3072);
        else body<3>(acc, rs, row0, cb, SGB, 2048, cb - 5120);
    }
};
struct EpiS1 {
    __device__ __forceinline__ void prefetch(const Unit&, int, int, int) const {}
    static constexpr int PROBE_ID = 2;
    static constexpr bool PERM = false;
    float* C;
    __device__ __forceinline__ void operator()(Acc& acc, const Unit& u, int wr, int wc, int fr, int fq, int par) const {
        const int row0 = u.arow + wr * 64 + fr, col0 = wc * 32 + 4 * fq;
#pragma unroll
        for (int ai = 0; ai < 2; ++ai)
#pragma unroll
            for (int m = 0; m < 4; ++m) { float* rowp = C + (size_t)(row0 + ai * HALF + m * 16) * 256 + col0;
#pragma unroll
                for (int bj = 0; bj < 2; ++bj)
#pragma unroll
                    for (int n = 0; n < 2; ++n) *(f32x4*)(rowp + bj * HALF + n * 16) = acc[ai][bj][m][n]; }
    }
};
struct EpiS2 {
    __device__ __forceinline__ void prefetch(const Unit&, int, int, int) const {}
    static constexpr int PROBE_ID = 3;
    static constexpr bool PERM = true;
    bf16_t* YG;
    __device__ __forceinline__ void operator()(Acc& acc, const Unit& u, int wr, int wc, int fr, int fq, int par) const {
        const int cr0 = u.pm * BM + wr * 64 + fr, nb = u.pn * BM + wc * 32 + 8 * fq;
#pragma unroll
        for (int ai = 0; ai < 2; ++ai)
#pragma unroll
            for (int m = 0; m < 4; ++m) { const int cr = cr0 + ai * HALF + m * 16;
#pragma unroll
                for (int bj = 0; bj < 2; ++bj) { f32x4 v0 = acc[ai][bj][m][0], v1 = acc[ai][bj][m][1];
                    gelu8(v0, v1);
                    const int n = nb + bj * HALF, t = n >> 4, i0 = n & 15;
                    *(u32x4*)(YG + (size_t)(cr * SL + t) * 1024 + u.g * 16 + i0) = pack8(v0, v1); } }
    }
};
template <int MODE> struct EpiMul {
    __device__ __forceinline__ void prefetch(const Unit&, int, int, int) const {}
    static constexpr int PROBE_ID = 10 + MODE;
    static constexpr bool PERM = true;
    bf16_t* O; const bf16_t* X1; int ld;
    __device__ __forceinline__ void operator()(Acc& acc, const Unit& u, int wr, int wc, int fr, int fq, int par) const {
        const int row0 = u.pm * BM + wr * 64 + fr, col0 = u.pn * BM + wc * 32 + 8 * fq;
        constexpr int MB = (MODE == 2) ? 2 : 4;
#pragma unroll
        for (int ai = 0; ai < 2; ++ai)
#pragma unroll
            for (int mb = 0; mb < 4; mb += MB) {
                u32x4 xv[MB][2], ov[MB][2];
#pragma unroll
                for (int mm = 0; mm < MB; ++mm)
#pragma unroll
                    for (int bj = 0; bj < 2; ++bj) { const size_t ro = (size_t)(row0 + ai * HALF + (mb + mm) * 16) * ld + col0 + bj * HALF;
                        xv[mm][bj] = *(const u32x4*)(X1 + ro); if (MODE == 2) ov[mm][bj] = *(const u32x4*)(O + ro); }
#pragma unroll
                for (int mm = 0; mm < MB; ++mm) { const int m = mb + mm; const size_t ro = (size_t)(row0 + ai * HALF + m * 16) * ld + col0;
#pragma unroll
                    for (int bj = 0; bj < 2; ++bj) { f32x4 v0 = acc[ai][bj][m][0], v1 = acc[ai][bj][m][1], x0, x1;
                        unpack8(xv[mm][bj], x0, x1);
                        if (MODE == 0) sigmoid8(v0, v1);
                        v0 = v0 * x0; v1 = v1 * x1;
                        if (MODE == 2) { f32x4 t0, t1; unpack8(ov[mm][bj], t0, t1); v0 = v0 + t0; v1 = v1 + t1; }
                        *(u32x4*)(O + ro + bj * HALF) = pack8(v0, v1); } }
            }
    }
};
struct EpiRes {
    __device__ __forceinline__ void prefetch(const Unit&, int, int, int) const {}
    static constexpr int PROBE_ID = 5;
    static constexpr bool PERM = true;
    bf16_t* XB; u64* RS;
    __device__ __forceinline__ void operator()(Acc& acc, const Unit& u, int wr, int wc, int fr, int fq, int par) const {
        const int row0 = u.pm * BM + wr * 64 + fr, col0 = u.pn * BM + wc * 32 + 8 * fq;
#pragma unroll
        for (int ai = 0; ai < 2; ++ai) {
            u32x4 old[4][2];
#pragma unroll
            for (int m = 0; m < 4; ++m)
#pragma unroll
                for (int bj = 0; bj < 2; ++bj) old[m][bj] = *(const u32x4*)(XB + (size_t)(row0 + ai * HALF + m * 16) * D + col0 + bj * HALF);
#pragma unroll
            for (int m = 0; m < 4; ++m) { const int r = row0 + ai * HALF + m * 16; const size_t ro = (size_t)r * D + col0; float ss = 0.f;
#pragma unroll
                for (int bj = 0; bj < 2; ++bj) { f32x4 x0, x1; unpack8(old[m][bj], x0, x1); const f32x4 v0 = x0 + acc[ai][bj][m][0], v1 = x1 + acc[ai][bj][m][1];
                    ss += (v0[0] * v0[0] + v0[1] * v0[1]) + (v0[2] * v0[2] + v0[3] * v0[3]) + (v1[0] * v1[0] + v1[1] * v1[1]) + (v1[2] * v1[2] + v1[3] * v1[3]);
                    *(u32x4*)(XB + ro + bj * HALF) = pack8(v0, v1); }
                ss += __shfl_xor(ss, 16); ss += __shfl_xor(ss, 32);
                if (fq == 0) (void)__hip_atomic_fetch_add(RS + r, (u64)(ss * RSS_SCALE), __ATOMIC_RELAXED, __HIP_MEMORY_SCOPE_AGENT); }
        }
    }
};
struct EpiUp {
    static constexpr int PROBE_ID = 6;
    static constexpr bool PERM = true;
    bf16_t* ACT; float* EDGE; const float* cw; const u64* RS; LAS unsigned char* side;
    __device__ __forceinline__ void prefetch(const Unit& u, int wid, int lane, int par) const {
        if (wid < 2) __builtin_amdgcn_global_load_lds((const unsigned*)(RS + u.pm * BM + wid * 128 + lane * 2), (LAS unsigned*)(side + par * SIDE_BYTES + wid * 1024), 16, 0, 0);
        else if (wid < 5) __builtin_amdgcn_global_load_lds((const unsigned*)(cw + (size_t)(wid - 2) * F2 + (lane >> 5) * FH + u.pn * HALF + (lane & 31) * 4), (LAS unsigned*)(side + par * SIDE_BYTES + 2048 + (wid - 2) * 1024), 16, 0, 0);
    }
    LAS float* xch;
    __device__ __forceinline__ void operator()(Acc& acc, const Unit& u, int wr, int wc, int fr, int fq, int par) const {
        const int wid = wr * 4 + wc, pw = (1 - wr) * 4 + wc;
        const int gc0 = u.pn * HALF + wc * 32 + 8 * fq;
        const bool second = (par & 2) != 0; par &= 1;
        if (!second)
#pragma unroll
        for (int ai = 0; ai < 2; ++ai)
#pragma unroll
            for (int m = 0; m < 4; ++m) { const float rsv = __builtin_amdgcn_rsqf(rss_mean(*(const LAS u64*)(side + par * SIDE_BYTES + (ai * HALF + wr * 64 + m * 16 + fr) * 8)) + EPS);
#pragma unroll
                for (int bj = 0; bj < 2; ++bj) { acc[ai][bj][m][0] = acc[ai][bj][m][0] * rsv; acc[ai][bj][m][1] = acc[ai][bj][m][1] * rsv; } }
#pragma unroll
        for (int ai = 0; ai < 2; ++ai) {
            if (fr == 0) { LAS f32x4* p = (LAS f32x4*)(xch + (((wid * 2 + ai) * 2 + 0) * 4 + fq) * 16);
                p[0] = acc[ai][0][0][0]; p[1] = acc[ai][0][0][1]; p[2] = acc[ai][1][0][0]; p[3] = acc[ai][1][0][1]; }
            if (fr == 15) { LAS f32x4* p = (LAS f32x4*)(xch + (((wid * 2 + ai) * 2 + 1) * 4 + fq) * 16);
                p[0] = acc[ai][0][3][0]; p[1] = acc[ai][0][3][1]; p[2] = acc[ai][1][3][0]; p[3] = acc[ai][1][3][1]; }
        }
        {
            float* eb = EDGE + (size_t)u.pm * 4 * 2 * FH + gc0;
            if (wr == 0 && fr < 2) {
#pragma unroll
                for (int bj = 0; bj < 2; ++bj) { float* p = eb + (size_t)(fr * 2 + bj) * FH; *(f32x4*)p = acc[0][bj][0][0]; *(f32x4*)(p + 4) = acc[0][bj][0][1]; } }
            if (wr == 1 && fr >= 14) {
#pragma unroll
                for (int bj = 0; bj < 2; ++bj) { float* p = eb + (size_t)((fr - 12) * 2 + bj) * FH; *(f32x4*)p = acc[1][bj][3][0]; *(f32x4*)(p + 4) = acc[1][bj][3][1]; } }
        }
        unsigned wpk[3][2][4];
#pragma unroll
        for (int k = 0; k < 3; ++k)
#pragma unroll
            for (int bj = 0; bj < 2; ++bj) { const LAS float* p = (const LAS float*)(side + par * SIDE_BYTES + 2048 + k * 1024 + bj * 512) + wc * 32 + 8 * fq; const f32x4 a = *(const LAS f32x4*)p, b = *(const LAS f32x4*)(p + 4);
                wpk[k][bj][0] = cvt_pk_bf16(a[0], a[1]); wpk[k][bj][1] = cvt_pk_bf16(a[2], a[3]); wpk[k][bj][2] = cvt_pk_bf16(b[0], b[1]); wpk[k][bj][3] = cvt_pk_bf16(b[2], b[3]); }
        asm volatile("s_waitcnt lgkmcnt(0)" ::: "memory"); __builtin_amdgcn_s_barrier(); asm volatile("" ::: "memory");
        const unsigned long long m15 = __builtin_amdgcn_ballot_w64(fr == 15), m00 = __builtin_amdgcn_ballot_w64(fr == 0);
        u32x2 keep[2][4];
#pragma unroll
        for (int n = 0; n < 2; ++n) {
            f32x4 wv[3][2];
#pragma unroll
            for (int k = 0; k < 3; ++k)
#pragma unroll
                for (int bj = 0; bj < 2; ++bj) wv[k][bj] = (f32x4){bf_lo(wpk[k][bj][2 * n]), bf_hi(wpk[k][bj][2 * n]), bf_lo(wpk[k][bj][2 * n + 1]), bf_hi(wpk[k][bj][2 * n + 1])};
#pragma unroll
            for (int ai = 0; ai < 2; ++ai)
#pragma unroll
                for (int m = 0; m < 4; ++m) {
                    const bool up_out = (wr == 0 && ai == 0), dn_out = (wr == 1 && ai == 1);
                    const LAS f32x4* pu = (const LAS f32x4*)(xch + (((pw * 2 + ((wr == 0) ? 0 : ai)) * 2 + 1) * 4 + fq) * 16);
                    const LAS f32x4* pd = (const LAS f32x4*)(xch + (((pw * 2 + ((wr == 0) ? ai : 1)) * 2 + 0) * 4 + fq) * 16);
                    f32x4 h[2];
#pragma unroll
                    for (int bj = 0; bj < 2; ++bj) {
                        f32x4 upv, dnv; const f32x4 c = acc[ai][bj][m][n];
                        if (m > 0) upv = acc[ai][bj][m > 0 ? m - 1 : 0][n]; else upv = up_out ? (f32x4){0.f, 0.f, 0.f, 0.f} : pu[bj * 2 + n];
                        if (m < 3) dnv = acc[ai][bj][m < 3 ? m + 1 : 3][n]; else dnv = dn_out ? (f32x4){0.f, 0.f, 0.f, 0.f} : pd[bj * 2 + n];
                        float h0, h1, h2, h3, t0, t1, t2, t3;
                        asm volatile("v_cndmask_b32 %4, %8, %12, %24\n\tv_cndmask_b32 %5, %9, %13, %24\n\tv_cndmask_b32 %6, %10, %14, %24\n\tv_cndmask_b32 %7, %11, %15, %24\n\t"
                                     "v_mul_f32 %0, %16, %8\n\tv_mul_f32 %1, %17, %9\n\tv_mul_f32 %2, %18, %10\n\tv_mul_f32 %3, %19, %11\n\t"
                                     "v_fmac_f32_dpp %0, %4, %20 row_ror:1 row_mask:0xf bank_mask:0xf\n\tv_fmac_f32_dpp %1, %5, %21 row_ror:1 row_mask:0xf bank_mask:0xf\n\t"
                                     "v_fmac_f32_dpp %2, %6, %22 row_ror:1 row_mask:0xf bank_mask:0xf\n\tv_fmac_f32_dpp %3, %7, %23 row_ror:1 row_mask:0xf bank_mask:0xf"
                                     : "=&v"(h0), "=&v"(h1), "=&v"(h2), "=&v"(h3), "=&v"(t0), "=&v"(t1), "=&v"(t2), "=&v"(t3)
                                     : "v"(c[0]), "v"(c[1]), "v"(c[2]), "v"(c[3]), "v"(upv[0]), "v"(upv[1]), "v"(upv[2]), "v"(upv[3]),
                                       "v"(wv[1][bj][0]), "v"(wv[1][bj][1]), "v"(wv[1][bj][2]), "v"(wv[1][bj][3]), "v"(wv[0][bj][0]), "v"(wv[0][bj][1]), "v"(wv[0][bj][2]), "v"(wv[0][bj][3]), "s"(m15));
                        asm volatile("v_cndmask_b32 %4, %8, %12, %20\n\tv_cndmask_b32 %5, %9, %13, %20\n\tv_cndmask_b32 %6, %10, %14, %20\n\tv_cndmask_b32 %7, %11, %15, %20\n\t"
                                     "v_fmac_f32_dpp %0, %4, %16 row_ror:15 row_mask:0xf bank_mask:0xf\n\tv_fmac_f32_dpp %1, %5, %17 row_ror:15 row_mask:0xf bank_mask:0xf\n\t"
                                     "v_fmac_f32_dpp %2, %6, %18 row_ror:15 row_mask:0xf bank_mask:0xf\n\tv_fmac_f32_dpp %3, %7, %19 row_ror:15 row_mask:0xf bank_mask:0xf"
                                     : "+v"(h0), "+v"(h1), "+v"(h2), "+v"(h3), "=&v"(t0), "=&v"(t1), "=&v"(t2), "=&v"(t3)
                                     : "v"(c[0]), "v"(c[1]), "v"(c[2]), "v"(c[3]), "v"(dnv[0]), "v"(dnv[1]), "v"(dnv[2]), "v"(dnv[3]),
                                       "v"(wv[2][bj][0]), "v"(wv[2][bj][1]), "v"(wv[2][bj][2]), "v"(wv[2][bj][3]), "s"(m00));
                        h[bj] = (f32x4){h0, h1, h2, h3};
                    }
                    f32x4 o; { f32x4 tq = h[0] * (h[0] * h[0] * -0.10294324f + -2.3022082f);
#pragma unroll
                        for (int j = 0; j < 4; ++j) tq[j] = __builtin_amdgcn_exp2f(tq[j]);
                        tq = tq + 1.0f;
#pragma unroll
                        for (int j = 0; j < 4; ++j) tq[j] = __builtin_amdgcn_rcpf(tq[j]);
                        o = h[0] * tq * h[1]; }
                    u32x2 pk; pk.x = cvt_pk_bf16(o[0], o[1]); pk.y = cvt_pk_bf16(o[2], o[3]);
                    if (n == 0) keep[ai][m] = pk;
                    else { const int r = u.pm * BM + ai * HALF + wr * 64 + m * 16 + fr; u32x4 w4; w4.x = keep[ai][m].x; w4.y = keep[ai][m].y; w4.z = pk.x; w4.w = pk.y; *(u32x4*)(ACT + (size_t)r * FH + gc0) = w4; }
                }
        }
    }
};
}

struct Args {
    const float* in[28]; float* out; unsigned char* ws; int ph_lo, ph_hi;
};
struct Ptrs {
    const __attribute__((address_space(4))) Args* a;
    __device__ __forceinline__ const float* x_prompt() const { return (const float*)(GAS const float*)a->in[0]; }
    __device__ __forceinline__ const float* x_sample() const { return (const float*)(GAS const float*)a->in[1]; }
    __device__ __forceinline__ const float* norm1_g() const { return (const float*)(GAS const float*)a->in[2]; }
    __device__ __forceinline__ const float* w_in() const { return (const float*)(GAS const float*)a->in[3]; }
    __device__ __forceinline__ const float* s5_a_re() const { return (const float*)(GAS const float*)a->in[4]; }
    __device__ __forceinline__ const float* s5_a_im() const { return (const float*)(GAS const float*)a->in[5]; }
    __device__ __forceinline__ const float* s5_log_dt() const { return (const float*)(GAS const float*)a->in[6]; }
    __device__ __forceinline__ const float* s5_b_re() const { return (const float*)(GAS const float*)a->in[7]; }
    __device__ __forceinline__ const float* s5_b_im() const { return (const float*)(GAS const float*)a->in[8]; }
    __device__ __forceinline__ const float* s5_c_re() const { return (const float*)(GAS const float*)a->in[9]; }
    __device__ __forceinline__ const float* s5_c_im() const { return (const float*)(GAS const float*)a->in[10]; }
    __device__ __forceinline__ const float* s5_d() const { return (const float*)(GAS const float*)a->in[11]; }
    __device__ __forceinline__ const float* s5_w_glu() const { return (const float*)(GAS const float*)a->in[12]; }
    __device__ __forceinline__ const float* lru_conv_w() const { return (const float*)(GAS const float*)a->in[13]; }
    __device__ __forceinline__ const float* lru_conv_b() const { return (const float*)(GAS const float*)a->in[14]; }
    __device__ __forceinline__ const float* lru_w_a() const { return (const float*)(GAS const float*)a->in[15]; }
    __device__ __forceinline__ const float* lru_b_a() const { return (const float*)(GAS const float*)a->in[16]; }
    __device__ __forceinline__ const float* lru_w_x() const { return (const float*)(GAS const float*)a->in[17]; }
    __device__ __forceinline__ const float* lru_b_x() const { return (const float*)(GAS const float*)a->in[18]; }
    __device__ __forceinline__ const float* lru_lambda() const { return (const float*)(GAS const float*)a->in[19]; }
    __device__ __forceinline__ const float* w_proj_a() const { return (const float*)(GAS const float*)a->in[20]; }
    __device__ __forceinline__ const float* w_proj_b() const { return (const float*)(GAS const float*)a->in[21]; }
    __device__ __forceinline__ const float* w_out() const { return (const float*)(GAS const float*)a->in[22]; }
    __device__ __forceinline__ const float* norm2_g() const { return (const float*)(GAS const float*)a->in[23]; }
    __device__ __forceinline__ const float* ffn_w_up() const { return (const float*)(GAS const float*)a->in[24]; }
    __device__ __forceinline__ const float* ffn_conv_w() const { return (const float*)(GAS const float*)a->in[25]; }
    __device__ __forceinline__ const float* ffn_w_down() const { return (const float*)(GAS const float*)a->in[26]; }
    __device__ __forceinline__ const float* final_g() const { return (const float*)(GAS const float*)a->in[27]; }
};

__device__ __forceinline__ void transpose_item(const float* W, int K, int N, bf16_t* WT, int k0, int n0s, int n0d, const float* gain, float* scr, int lane) {
    const int kr = lane >> 3, n4 = (lane & 7) * 4;
    f32x4 v[8];
#pragma unroll
    for (int i = 0; i < 8; ++i) v[i] = *(const f32x4*)(W + (size_t)(k0 + 8 * i + kr) * N + n0s + n4);
#pragma unroll
    for (int i = 0; i < 8; ++i) { const int kk = 8 * i + kr; const float gsc = gain ? gain[k0 + kk] : 1.0f; float* d = scr + kk * 33 + n4; d[0] = v[i][0] * gsc; d[1] = v[i][1] * gsc; d[2] = v[i][2] * gsc; d[3] = v[i][3] * gsc; }
    asm volatile("s_waitcnt lgkmcnt(0)" ::: "memory");
    const int c = lane & 7;
#pragma unroll
    for (int j = 0; j < 4; ++j) { const int n = (lane >> 3) + 8 * j; const float* s = scr + (8 * c) * 33 + n;
        u32x4 o; o.x = cvt_pk_bf16(s[0 * 33], s[1 * 33]); o.y = cvt_pk_bf16(s[2 * 33], s[3 * 33]); o.z = cvt_pk_bf16(s[4 * 33], s[5 * 33]); o.w = cvt_pk_bf16(s[6 * 33], s[7 * 33]);
        *(u32x4*)(WT + (size_t)(n0d + n) * K + k0 + 8 * c) = o; }
    asm volatile("s_waitcnt lgkmcnt(0)" ::: "memory");
}
__device__ __forceinline__ void transpose_all(const float* W, int K, int N, unsigned char* ws, size_t woff, bool up_perm, const float* gain, float* scr, int lane, int gw, int ngw) {
    const int nblk = N / 32, per = (K / 64) * nblk, total = DEPTH * per;
    for (int it = gw; it < total; it += ngw) {
        const int l = it / per, r = it % per, kb = r / nblk, nb = r % nblk, n0d = nb * 32;
        int n0s = n0d;
        if (up_perm) { const int tile = n0d >> 8, wi = n0d & 255; n0s = (wi < 128) ? tile * 128 + wi : FH + tile * 128 + (wi - 128); }
        transpose_item(W + (size_t)l * K * N, K, N, (bf16_t*)(ws + WS_W + (size_t)l * WL_STRIDE + woff), kb * 64, n0s, n0d, gain ? gain + (size_t)l * K : nullptr, scr, lane);
    }
}

__device__ __forceinline__ void s5_prep_item(const Ptrs& P, unsigned char* ws, int l, int g, float* lds, int tid) {
    float* Ktab = lds;
    float* apr = lds + 16384;
    float* api = apr + 2 * 33 * 64;
    float* bbr = api + 2 * 33 * 64;
    float* bbi = bbr + 2 * 64 * 16;
    float* ccr = bbi + 2 * 64 * 16;
    float* cci = ccr + 2 * 16 * 65;
    for (int idx = tid; idx < 2 * 16 * 64; idx += 512) { const int d = idx >> 10, i = (idx >> 6) & 15, p = idx & 63; const size_t o = (((size_t)(l * 2 + d) * SG + g) * SH + i) * SP + p;
        ccr[(d * 16 + i) * 65 + p] = P.s5_c_re()[o]; cci[(d * 16 + i) * 65 + p] = P.s5_c_im()[o]; }
    for (int idx = tid; idx < 2 * 33 * 64; idx += 512) {
        const int d = idx / (33 * 64), r = idx % (33 * 64), tau = r / 64, p = r % 64;
        const size_t o = ((size_t)(l * 2 + d) * SG + g) * SP + p;
        const float dt = __expf(P.s5_log_dt()[(l * 2 + d) * SG + g]);
        const float x = P.s5_a_re()[o] * dt * (float)tau, y = P.s5_a_im()[o] * dt * (float)tau;
        const float e = expf(x); float sn, cs; sincosf(y, &sn, &cs);
        apr[idx] = e * cs; api[idx] = e * sn;
    }
    for (int idx = tid; idx < 2 * 64 * 16; idx += 512) {
        const int d = idx / 1024, p = (idx % 1024) / 16, j = idx % 16;
        const size_t o = ((size_t)(l * 2 + d) * SG + g) * SP + p;
        const float dt = expf(P.s5_log_dt()[(l * 2 + d) * SG + g]);
        const float lr = P.s5_a_re()[o], li = P.s5_a_im()[o], x = lr * dt, y = li * dt;
        float sn, cs; sincosf(y, &sn, &cs); float sh, ch; sincosf(0.5f * y, &sh, &ch);
        const float nr = expm1f(x) * cs - 2.0f * sh * sh, ni = expf(x) * sn;
        const float den = 1.0f / (lr * lr + li * li);
        const float qr = (nr * lr + ni * li) * den, qi = (ni * lr - nr * li) * den;
        const float br = P.s5_b_re()[o * 16 + j], bi = P.s5_b_im()[o * 16 + j];
        bbr[idx] = qr * br - qi * bi; bbi[idx] = qr * bi + qi * br;
    }
    __syncthreads();
#pragma unroll 1
    for (int cb = tid; cb < 2 * 32 * 16; cb += 512) {
        const int d = cb >> 9, tau = (cb >> 4) & 31, i = cb & 15;
        const float* ar_ = apr + (d * 33 + tau) * 64; const float* ai_ = api + (d * 33 + tau) * 64; const float* cr_ = ccr + (d * 16 + i) * 65; const float* ci_ = cci + (d * 16 + i) * 65;
        f32x4 acc4[4] = {(f32x4){0.f, 0.f, 0.f, 0.f}, (f32x4){0.f, 0.f, 0.f, 0.f}, (f32x4){0.f, 0.f, 0.f, 0.f}, (f32x4){0.f, 0.f, 0.f, 0.f}};
#pragma unroll 4
        for (int p = 0; p < 64; ++p) {
            const float ar = ar_[p], ai = ai_[p], cr = cr_[p], ci = ci_[p];
            const float er = cr * ar - ci * ai, ei = cr * ai + ci * ar;
            const f32x4* br4 = (const f32x4*)(bbr + (d * 64 + p) * 16); const f32x4* bi4 = (const f32x4*)(bbi + (d * 64 + p) * 16);
#pragma unroll
            for (int v = 0; v < 4; ++v) acc4[v] = acc4[v] + br4[v] * er - bi4[v] * ei;
        }
        f32x4* o = (f32x4*)(Ktab + ((d * 32 + tau) * 16 + i) * 16);
#pragma unroll
        for (int v = 0; v < 4; ++v) o[v] = acc4[v];
    }
    __syncthreads();
    bf16_t* Bt2 = (bf16_t*)(ws + WS_S5 + (size_t)l * S5_STRIDE + S5_BT2) + (size_t)g * 512 * UHW;
    for (int pc = tid; pc < 512 * (UHW / 8); pc += 512) {
        const int n = pc / (UHW / 8), k8 = pc % (UHW / 8), t = n >> 4, i = n & 15;
        float v[8];
        if (k8 < 64) {
            const int s = k8 >> 1, j0 = (k8 & 1) * 8;
#pragma unroll
            for (int e = 0; e < 8; ++e) { const int j = j0 + e; float x;
                if (s < t) x = Ktab[(0 * 32 + (t - s)) * 256 + i * 16 + j];
                else if (s > t) x = Ktab[(1 * 32 + (s - t)) * 256 + i * 16 + j];
                else { x = Ktab[i * 16 + j] + Ktab[8192 + i * 16 + j]; if (i == j) x += P.s5_d()[(size_t)l * 1024 + g * 16 + i]; }
                v[e] = x; }
        } else {
            const int kk = (k8 - 64) * 8, sel = kk >> 6, p0 = kk & 63, d = sel >> 1, ex = d ? (32 - t) : (t + 1);
            const float* cr = ccr + (d * 16 + i) * 65; const float* ci = cci + (d * 16 + i) * 65;
#pragma unroll
            for (int e = 0; e < 8; ++e) { const int p = p0 + e; const float ar = apr[(d * 33 + ex) * 64 + p], ai = api[(d * 33 + ex) * 64 + p];
                const float wr_ = cr[p] * ar - ci[p] * ai, wi_ = cr[p] * ai + ci[p] * ar;
                v[e] = (sel & 1) ? -wi_ : wr_; }
        }
        u32x4 o; o.x = cvt_pk_bf16(v[0], v[1]); o.y = cvt_pk_bf16(v[2], v[3]); o.z = cvt_pk_bf16(v[4], v[5]); o.w = cvt_pk_bf16(v[6], v[7]);
        *(u32x4*)(Bt2 + (size_t)n * UHW + k8 * 8) = o;
    }
    bf16_t* Bt1 = (bf16_t*)(ws + WS_S5 + (size_t)l * S5_STRIDE + S5_BT1) + (size_t)g * 256 * 512;
    for (int pc = tid; pc < 256 * 64; pc += 512) {
        const int n = pc / 64, k8 = pc % 64, sel = n >> 6, p = n & 63, d = sel >> 1, s = k8 >> 1, j0 = (k8 & 1) * 8, ex = d ? s : (31 - s);
        const float ar = apr[(d * 33 + ex) * 64 + p], ai = api[(d * 33 + ex) * 64 + p];
        float v[8];
#pragma unroll
        for (int e = 0; e < 8; ++e) { const float br = bbr[(d * 64 + p) * 16 + j0 + e], bi = bbi[(d * 64 + p) * 16 + j0 + e];
            v[e] = (sel & 1) ? (ar * bi + ai * br) : (ar * br - ai * bi); }
        u32x4 o; o.x = cvt_pk_bf16(v[0], v[1]); o.y = cvt_pk_bf16(v[2], v[3]); o.z = cvt_pk_bf16(v[4], v[5]); o.w = cvt_pk_bf16(v[6], v[7]);
        *(u32x4*)(Bt1 + (size_t)n * 512 + k8 * 8) = o;
    }
    __syncthreads();
}

__device__ __forceinline__ void lru_prep(const Ptrs& P, unsigned char* ws, int gt, int ngt) {
    for (int idx = gt; idx < DEPTH * 2 * 1024; idx += ngt) { const float lam = P.lru_lambda()[idx]; ((float*)(ws + WS_C8V))[idx] = -8.0f * (lam > 15.f ? expf(-lam) : log1pf(expf(-lam))); }
    const int total = DEPTH * 16 * 8 * 4 * 64;
    for (int idx = gt; idx < total; idx += ngt) {
        const int lane = idx & 63, f = (idx >> 6) & 3, w = (idx >> 8) & 7, hb = (idx >> 11) & 15, l = idx >> 15;
        const int d = w >> 2, cs = w & 3, mat = f >> 1, ks = f & 1;
        const float* W = (mat ? P.lru_w_x() : P.lru_w_a()) + ((size_t)((l * 2 + d) * 16 + hb) * 64) * 64;
        float v[8];
#pragma unroll
        for (int e = 0; e < 8; ++e) v[e] = W[(size_t)(32 * ks + 8 * (lane >> 4) + e) * 64 + 16 * cs + (lane & 15)];
        u32x4 o; o.x = cvt_pk_bf16(v[0], v[1]); o.y = cvt_pk_bf16(v[2], v[3]); o.z = cvt_pk_bf16(v[4], v[5]); o.w = cvt_pk_bf16(v[6], v[7]);
        *(u32x4*)(ws + WS_LRUW + (size_t)idx * 16) = o;
    }
}

__device__ __forceinline__ void input_phase(const Ptrs& P, bf16_t* XB, u64* RS, int gw, int ngw, int lane) {
    for (int m = gw; m < T; m += ngw) {
        const float* src = m < 8192 ? P.x_prompt() + (size_t)m * D : P.x_sample() + (size_t)(m - 8192) * D;
        f32x4 v[8]; float s = 0.f;
#pragma unroll
        for (int j = 0; j < 4; ++j) { v[2 * j] = *(const f32x4*)(src + 8 * (lane + 64 * j)); v[2 * j + 1] = *(const f32x4*)(src + 8 * (lane + 64 * j) + 4); }
#pragma unroll
        for (int j = 0; j < 8; ++j) s += (v[j][0] * v[j][0] + v[j][1] * v[j][1]) + (v[j][2] * v[j][2] + v[j][3] * v[j][3]);
        s = wave_sum(s);
#pragma unroll
        for (int j = 0; j < 4; ++j) *(u32x4*)(XB + (size_t)m * D + 8 * (lane + 64 * j)) = pg8::pack8(v[2 * j], v[2 * j + 1]);
        if (lane == 0) RS[m] = (u64)(s * RSS_SCALE);
    }
}
__device__ __forceinline__ void final_norm_phase(float* OUT, const bf16_t* XB, const u64* RS, const float* gain, int gw, int ngw, int lane) {
    f32x4 gv[8];
#pragma unroll
    for (int j = 0; j < 4; ++j) { gv[2 * j] = *(const f32x4*)(gain + 8 * (lane + 64 * j)); gv[2 * j + 1] = *(const f32x4*)(gain + 8 * (lane + 64 * j) + 4); }
    for (int m = gw; m < T; m += ngw) {
        const float rstd = 1.0f / sqrtf(rss_mean(RS[m]) + EPS);
#pragma unroll
        for (int j = 0; j < 4; ++j) { f32x4 x0, x1; pg8::unpack8(*(const u32x4*)(XB + (size_t)m * D + 8 * (lane + 64 * j)), x0, x1);
            float* o = OUT + (size_t)m * D + 8 * (lane + 64 * j); *(f32x4*)o = x0 * rstd * gv[2 * j]; *(f32x4*)(o + 4) = x1 * rstd * gv[2 * j + 1]; }
    }
}

__device__ __forceinline__ bool seq_start(int m) { return m == 0 || (m >= 8192 && (m & 4095) == 0); }
__device__ __forceinline__ int seq_lo(int m) { return m < 8192 ? 0 : (m & ~4095); }
__device__ __forceinline__ int seq_hi(int m) { return m < 8192 ? 8192 : (m & ~4095) + 4096; }

constexpr int XC_LD = 68, XCB_LD = 72;
__device__ __forceinline__ float expm1_over_x_small(float x) { float p = 1.0f / 720.0f; p = p * x + 1.0f / 120.0f; p = p * x + 1.0f / 24.0f; p = p * x + 1.0f / 6.0f; p = p * x + 0.5f; return p * x + 1.0f; }
__device__ __forceinline__ float exp_small(float x) { float p = 1.0f / 5040.0f; p = p * x + 1.0f / 720.0f; p = p * x + 1.0f / 120.0f; p = p * x + 1.0f / 24.0f; p = p * x + 1.0f / 6.0f; p = p * x + 0.5f; p = p * x + 1.0f; return p * x + 1.0f; }
__device__ __forceinline__ float neg_expm1_small(float x) { float p = 1.0f / 362880.0f; p = p * x + 1.0f / 40320.0f; p = p * x + 1.0f / 5040.0f; p = p * x + 1.0f / 720.0f; p = p * x + 1.0f / 120.0f; p = p * x + 1.0f / 24.0f; p = p * x + 1.0f / 6.0f; p = p * x + 0.5f; p = p * x + 1.0f; return -x * p; }
__device__ __forceinline__ float lru_xch16(float x, bool qodd) { const unsigned u = __float_as_uint(x); const auto r = __builtin_amdgcn_permlane16_swap(u, u, false, false); return __uint_as_float(qodd ? r[0] : r[1]); }
__device__ __forceinline__ float lru_xch32(float x, bool upper) { const unsigned u = __float_as_uint(x); const auto r = __builtin_amdgcn_permlane32_swap(u, u, false, false); return __uint_as_float(upper ? r[0] : r[1]); }
template <int PASS> __device__ __forceinline__ int lru_phase(const Ptrs& P, unsigned char* ws, int l, int hb, unsigned* ctr, unsigned char* lds, volatile LAS unsigned* MISC, int tid) {
    int nproc = 0;
    float* XC = (float*)lds;
    bf16_t* XCB = (bf16_t*)(lds + 128 * XC_LD * 4);
    float* HF = (float*)(lds + 128 * XC_LD * 4 + 128 * XCB_LD * 2);
    float* HB = HF + 128 * XC_LD;
    const bf16_t* XR = (const bf16_t*)(ws + WS_R + R_XR);
    const int ch0 = hb * 64, lane = tid & 63, wid = tid >> 6;
    const int c8 = (tid & 7) * 8, r0 = tid >> 3;
    u32x4 cwk[4]; f32x4 cbv[2];
    { const float* cwp = P.lru_conv_w() + (size_t)l * 4 * 1024 + ch0 + c8; const float* cbp = P.lru_conv_b() + (size_t)l * 1024 + ch0 + c8;
#pragma unroll
      for (int k = 0; k < 4; ++k) cwk[k] = pg8::pack8(*(const f32x4*)(cwp + k * 1024), *(const f32x4*)(cwp + k * 1024 + 4));
      cbv[0] = *(const f32x4*)cbp; cbv[1] = *(const f32x4*)(cbp + 4); }
    const int d = wid >> 2, cs = wid & 3, q = lane >> 4, chl = cs * 16 + (lane & 15), ch = ch0 + chl;
    const bf16x8* wf = (const bf16x8*)(ws + WS_LRUW + ((size_t)((l * 16 + hb) * 8 + wid) * 4) * 1024) + lane;
    const bf16x8 ba0 = wf[0], ba1 = wf[64], bx0 = wf[128], bx1 = wf[192];
    const float b_a = P.lru_b_a()[(size_t)(l * 2 + d) * 1024 + ch], b_x = P.lru_b_x()[(size_t)(l * 2 + d) * 1024 + ch];
    const float b_a2 = b_a * -1.44269504f, b_x2 = b_x * -1.44269504f;
    const float c8v = ((const float*)(ws + WS_C8V))[(size_t)(l * 2 + d) * 1024 + ch];
    const bool small = c8v > -0.35f;
    const int qq = d ? 3 - q : q;
    const bool hi1 = (qq & 1) != 0, hi2 = (qq & 2) != 0, qodd = (q & 1) != 0, upper = lane >= 32;
#define XCH16(x) lru_xch16((x), qodd)
#define XCH32(x) lru_xch32((x), upper)

    unsigned n2 = 0;
    if (tid == 0) { const unsigned c0 = xb_add(ctr, 1u), c1 = xb_add(ctr, 1u); MISC[16] = c0; MISC[17] = c1; }
    __syncthreads();
    unsigned cur = MISC[16], nx1 = MISC[17];
    __syncthreads();
    u32x4 xpf[2][4];
    const unsigned rowoff = (unsigned)(r0 * 1024 + ch0 + c8) * 2u;
#define LRU_PREFETCH(tcx) do { const int t0p = (int)(tcx) * LT, lop = seq_lo(t0p), hip = seq_hi(t0p); \
        _Pragma("unroll") for (int it = 0; it < 2; ++it) _Pragma("unroll") for (int k = 0; k < 4; ++k) { const int ts = t0p + r0 + it * 64 + k - 2; \
            xpf[it][k] = (ts >= lop && ts < hip) ? *(const u32x4*)((const char*)XR + (rowoff + (unsigned)((t0p + it * 64 + k - 2) * 2048))) : (u32x4){0u, 0u, 0u, 0u}; } } while (0)
    if (cur < (unsigned)NTC) LRU_PREFETCH(cur);
    const bf16_t* GG = (const bf16_t*)(ws + WS_R + R_GG); bf16_t* YB = (bf16_t*)(ws + WS_R + R_YB);
    while (cur < (unsigned)NTC) {
        if (tid == 0) n2 = xb_add(ctr, 1u);
        const int tc = (int)cur, t0 = tc * LT;
        u32x4 ggv[2]; float carry = 0.f;
        if (PASS == 2) {
#pragma unroll
            for (int it = 0; it < 2; ++it) ggv[it] = *(const u32x4*)((const char*)GG + (rowoff + (unsigned)((t0 + it * 64) * 2048)));
            carry = *(const float*)((const char*)(ws + WS_R + R_CIN) + (unsigned)(((d * NTC + tc) * 1024 + ch) * 4));
        }
#pragma unroll
        for (int it = 0; it < 2; ++it) {
            const int r = r0 + it * 64;
            f32x4 a0 = cbv[0], a1 = cbv[1];
#pragma unroll
            for (int k = 0; k < 4; ++k) { f32x4 x0, x1, w0, w1; pg8::unpack8(xpf[it][k], x0, x1); pg8::unpack8(cwk[k], w0, w1); a0 = a0 + w0 * x0; a1 = a1 + w1 * x1; }
            *(f32x4*)(XC + r * XC_LD + c8) = a0; *(f32x4*)(XC + r * XC_LD + c8 + 4) = a1;
            *(u32x4*)(XCB + r * XCB_LD + c8) = pg8::pack8(a0, a1);
        }
        if (nx1 < (unsigned)NTC) LRU_PREFETCH(nx1);
        __syncthreads();
        f32x4 gr_[8], gg_[8];
#pragma unroll
        for (int mt = 0; mt < 8; ++mt) {
            const bf16x8 fa0 = *(const bf16x8*)(XCB + (mt * 16 + (lane & 15)) * XCB_LD + 8 * q), fa1 = *(const bf16x8*)(XCB + (mt * 16 + (lane & 15)) * XCB_LD + 32 + 8 * q);
            const f32x4 z = (f32x4){0.f, 0.f, 0.f, 0.f};
            gr_[mt] = __builtin_amdgcn_mfma_f32_16x16x32_bf16(fa0, ba0, z, 0, 0, 0); gr_[mt] = __builtin_amdgcn_mfma_f32_16x16x32_bf16(fa1, ba1, gr_[mt], 0, 0, 0);
            gg_[mt] = __builtin_amdgcn_mfma_f32_16x16x32_bf16(fa0, bx0, z, 0, 0, 0); gg_[mt] = __builtin_amdgcn_mfma_f32_16x16x32_bf16(fa1, bx1, gg_[mt], 0, 0, 0);
        }
        float totA = 1.0f, totB = 0.0f;
        float* Hout = d ? HB : HF;
#define LRU_TILE(mt, R0, R1, R2, R3) do { constexpr bool FASTP_ = false; \
            f32x4 ar = gr_[mt], ag = gg_[mt]; \
              \
            f32x4 xcv4; _Pragma("unroll") for (int rg = 0; rg < 4; ++rg) xcv4[rg] = XC[((mt) * 16 + 4 * q + rg) * XC_LD + chl]; \
            f32x4 tr = ar * -1.44269504f + b_a2, tg = ag * -1.44269504f + b_x2;            \
            _Pragma("unroll") for (int rg = 0; rg < 4; ++rg) { tr[rg] = __builtin_amdgcn_exp2f(tr[rg]); tg[rg] = __builtin_amdgcn_exp2f(tg[rg]); } \
            tr = tr + 1.0f; tg = tg + 1.0f; \
            _Pragma("unroll") for (int rg = 0; rg < 4; ++rg) { tr[rg] = __builtin_amdgcn_rcpf(tr[rg]); tg[rg] = __builtin_amdgcn_rcpf(tg[rg]); } \
            const f32x4 la4 = tr * c8v; \
            if (FASTP_ || small) { f32x4 p = la4 * (1.0f / 720.0f) + (1.0f / 120.0f); p = p * la4 + (1.0f / 24.0f); p = p * la4 + (1.0f / 6.0f); p = p * la4 + 0.5f; p = p * la4 + 1.0f; \
                const f32x4 am1 = la4 * p; ar = am1 + 1.0f; ag = -am1 * (am1 + 2.0f); }            \
            else { _Pragma("unroll") for (int rg = 0; rg < 4; ++rg) { ar[rg] = __expf(la4[rg]); ag[rg] = -expm1f(2.0f * la4[rg]); } } \
            _Pragma("unroll") for (int rg = 0; rg < 4; ++rg) ag[rg] = __builtin_amdgcn_sqrtf(ag[rg]); \
            ag = ag * tg * xcv4; \
            float A = ar[R0], B = ag[R0]; \
            B = B * ar[R1] + ag[R1]; A *= ar[R1]; B = B * ar[R2] + ag[R2]; A *= ar[R2]; B = B * ar[R3] + ag[R3]; A *= ar[R3]; \
              \
            const float Ap = XCH16(A), Bp = XCH16(B); \
            const float pairA = A * Ap, pairB = hi1 ? Bp * A + B : B * Ap + Bp;         \
            const float Ae1 = hi1 ? Ap : 1.0f, Be1 = hi1 ? Bp : 0.0f;                   \
            const float PAp = XCH32(pairA), PBp = XCH32(pairB); \
            const float At = pairA * PAp, Bt = hi2 ? PBp * pairA + pairB : pairB * PAp + PBp;     \
            if (PASS == 1) { totB = totB * At + Bt; totA *= At; } \
            else { \
                const float Ae = hi2 ? PAp * Ae1 : Ae1, Be = hi2 ? PBp * Ae1 + Be1 : Be1;     \
                float h = Ae * carry + Be;                                              \
                h = ar[R0] * h + ag[R0]; Hout[((mt) * 16 + 4 * q + R0) * XC_LD + chl] = h; \
                h = ar[R1] * h + ag[R1]; Hout[((mt) * 16 + 4 * q + R1) * XC_LD + chl] = h; \
                h = ar[R2] * h + ag[R2]; Hout[((mt) * 16 + 4 * q + R2) * XC_LD + chl] = h; \
                h = ar[R3] * h + ag[R3]; Hout[((mt) * 16 + 4 * q + R3) * XC_LD + chl] = h; \
                carry = At * carry + Bt; } \
        } while (0)
        if (d == 0) {
#pragma unroll
            for (int mt = 0; mt < 8; ++mt) LRU_TILE(mt, 0, 1, 2, 3);
        } else {
#pragma unroll
            for (int mt = 7; mt >= 0; --mt) LRU_TILE(mt, 3, 2, 1, 0);
        }
#undef LRU_TILE
#undef XCH16
#undef XCH32
        if (PASS == 1) {
            if (q == 0) *(f32x2*)((char*)(ws + WS_R + R_LSUM) + (unsigned)(((d * NTC + tc) * 1024 + ch) * 8)) = (f32x2){totA, totB};
        } else {
            __syncthreads();
#pragma unroll
            for (int it = 0; it < 2; ++it) {
                const int r = r0 + it * 64;
                f32x4 g0, g1; pg8::unpack8(ggv[it], g0, g1);
                const f32x4 y0 = (*(const f32x4*)(HF + r * XC_LD + c8) + *(const f32x4*)(HB + r * XC_LD + c8)) * g0, y1 = (*(const f32x4*)(HF + r * XC_LD + c8 + 4) + *(const f32x4*)(HB + r * XC_LD + c8 + 4)) * g1;
                *(u32x4*)((char*)YB + (rowoff + (unsigned)((t0 + it * 64) * 2048))) = pg8::pack8(y0, y1);
            }
        }
        if (tid == 0) MISC[16] = n2;
        __syncthreads();
        cur = nx1; nx1 = MISC[16]; ++nproc;
    }
#undef LRU_PREFETCH
    return nproc;
}

__device__ __forceinline__ void s5_chain(const Ptrs& P, unsigned char* ws, int l, int g, int d, int p, int c_lo, int n) {
    const size_t o = ((size_t)(l * 2 + d) * SG + g) * SP + p;
    const float dt = expf(P.s5_log_dt()[(l * 2 + d) * SG + g]);
    const float x = P.s5_a_re()[o] * dt * 32.0f, y = P.s5_a_im()[o] * dt * 32.0f;
    const float e = expf(x); float sn, cs; sincosf(y, &sn, &cs);
    const float ar = e * cs, ai = e * sn;
    const float* Sb = (const float*)(ws + WS_R + R_SBUF) + (size_t)g * NCR * 256 + d * 128 + p;
    bf16_t* Hb = (bf16_t*)(ws + WS_R + R_UH) + (size_t)g * NCR * UHW + 512 + d * 128 + p;
    float hr = 0.f, hi = 0.f;
    for (int c0 = 0; c0 < n; c0 += 8) {
        float sr[8], si[8];
#pragma unroll
        for (int j = 0; j < 8; ++j) { const int cr = d ? c_lo + n - 1 - (c0 + j) : c_lo + c0 + j; sr[j] = Sb[(size_t)cr * 256]; si[j] = Sb[(size_t)cr * 256 + 64]; }
#pragma unroll
        for (int j = 0; j < 8; ++j) { const int cr = d ? c_lo + n - 1 - (c0 + j) : c_lo + c0 + j;
            Hb[(size_t)cr * UHW] = (bf16_t)(cvt_pk_bf16(hr, 0.f) & 0xffffu); Hb[(size_t)cr * UHW + 64] = (bf16_t)(cvt_pk_bf16(hi, 0.f) & 0xffffu);
            const float nr = ar * hr - ai * hi + sr[j], ni = ar * hi + ai * hr + si[j]; hr = nr; hi = ni; }
    }
}
__device__ __forceinline__ void lru_chain(unsigned char* ws, int ch, int d, int sq) {
    const int c_lo = sq == 0 ? 0 : 64 + 32 * (sq - 1), n = sq == 0 ? 64 : 32;
    const float* Ls = (const float*)(ws + WS_R + R_LSUM) + ((size_t)d * NTC * 1024 + ch) * 2;
    float* Ci = (float*)(ws + WS_R + R_CIN) + (size_t)d * NTC * 1024 + ch;
    float carry = 0.f;
    for (int c0 = 0; c0 < n; c0 += 16) {
        f32x2 ab[16];
#pragma unroll
        for (int j = 0; j < 16; ++j) { const int tc = d ? c_lo + n - 1 - (c0 + j) : c_lo + c0 + j; ab[j] = *(const f32x2*)(Ls + (size_t)tc * 2048); }
#pragma unroll
        for (int j = 0; j < 16; ++j) { const int tc = d ? c_lo + n - 1 - (c0 + j) : c_lo + c0 + j; Ci[(size_t)tc * 1024] = carry; carry = ab[j][0] * carry + ab[j][1]; }
    }
}
__device__ __forceinline__ bool count_in_last(unsigned* cnt, unsigned add, unsigned target, volatile LAS unsigned* MISC, int tid) {
    asm volatile("s_waitcnt vmcnt(0)" ::: "memory");
    __syncthreads();
    if (tid == 0) {
        __builtin_amdgcn_fence(__ATOMIC_RELEASE, "agent");
        asm volatile("s_waitcnt vmcnt(0)" ::: "memory");
        const unsigned old = xb_add(cnt, add);
        const unsigned last = (add != 0u && old + add == target) ? 1u : 0u;
        if (last) { __builtin_amdgcn_fence(__ATOMIC_ACQUIRE, "agent"); asm volatile("s_waitcnt vmcnt(0)" ::: "memory"); }
        MISC[20] = last;
    }
    __syncthreads();
    const bool r = MISC[20] != 0u;
    __syncthreads();
    return r;
}

__device__ __forceinline__ void fix_rows_of_panel(const Ptrs& P, unsigned char* ws, int l, int pm, int tid) {
    const float* EDGE = (const float*)(ws + WS_R + R_EDGE); bf16_t* ACT = (bf16_t*)(ws + WS_R + R_ACT); const float* cw = P.ffn_conv_w() + (size_t)l * 3 * F2;
    for (int idx = tid; idx < 2 * (FH / 4); idx += 512) {
        const int c4 = (idx % (FH / 4)) * 4, which = idx / (FH / 4);
        const int b = pm + which; if (b < 1 || b > 95 || seq_start(b * 256)) continue;
        const float* e0 = which ? EDGE + ((size_t)pm * 4 + 2) * 2 * FH : EDGE + ((size_t)(pm - 1) * 4 + 3) * 2 * FH;
        const float* e1 = which ? EDGE + ((size_t)pm * 4 + 3) * 2 * FH : EDGE + ((size_t)pm * 4 + 0) * 2 * FH;
        const float* e2 = which ? EDGE + ((size_t)(pm + 1) * 4 + 0) * 2 * FH : EDGE + ((size_t)pm * 4 + 1) * 2 * FH;
        const f32x4 pg = *(const f32x4*)(e0 + c4), cg = *(const f32x4*)(e1 + c4), ng = *(const f32x4*)(e2 + c4);
        const f32x4 hg = *(const f32x4*)(cw + c4) * pg + *(const f32x4*)(cw + F2 + c4) * cg + *(const f32x4*)(cw + 2 * F2 + c4) * ng;
        const f32x4 pv = *(const f32x4*)(e0 + FH + c4), cv = *(const f32x4*)(e1 + FH + c4), nv = *(const f32x4*)(e2 + FH + c4);
        const f32x4 hv = *(const f32x4*)(cw + FH + c4) * pv + *(const f32x4*)(cw + F2 + FH + c4) * cv + *(const f32x4*)(cw + 2 * F2 + FH + c4) * nv;
        u32x2 o; o.x = cvt_pk_bf16(gelu_tanh(hg[0]) * hv[0], gelu_tanh(hg[1]) * hv[1]); o.y = cvt_pk_bf16(gelu_tanh(hg[2]) * hv[2], gelu_tanh(hg[3]) * hv[3]);
        *(u32x2*)(ACT + (size_t)(pm * 256 + which * 255) * FH + c4) = o;
    }
}

__global__ void __launch_bounds__(512, 2) fwd(Args args) {
    extern __shared__ __attribute__((aligned(16))) unsigned char lds[];
    const int wave_s = __builtin_amdgcn_readfirstlane((int)threadIdx.x >> 6);
    const int G = gridDim.x, bx = blockIdx.x;
#define WAVE_OF(td) __builtin_amdgcn_readfirstlane((td) >> 6)
    LAS unsigned char* ldsl = (LAS unsigned char*)lds;
    volatile LAS unsigned* MISC = (volatile LAS unsigned*)(ldsl + MISC_OFF);
    { const int t0_ = tid_of(wave_s); if (t0_ < 64) MISC[t0_] = 0u; }
    __syncthreads();
    const int lo = args.ph_lo, hi = args.ph_hi;
    XcdBarrier bar; bar.bar = (unsigned*)(args.ws + WS_CTL) + CW_BAR; bar.x = 0; bar.st = MISC + 8;
    if (hi - lo > 1) bar = xcd_barrier_post((unsigned*)(args.ws + WS_CTL) + CW_BAR, MISC + 8);
#ifndef PH_MASK
#define PH_MASK 0xFFFF
#endif
#define EN(k) (((PH_MASK) >> (k)) & 1)
#ifndef PROBE_REP
#define PROBE_REP -1
#endif
#define NREP(k) (((k) == (PROBE_REP)) ? 2 : 1)
#define RUN(p) (lo <= (p) && (p) < hi)
#ifdef PROBE_TIME
    long long tph = wall_clock64();
#ifdef PROBE_SKEW
#define PROBE_SKEW_SPIN(p) do { if (bx == 0 && (p) == (PROBE_TIME)) { unsigned* cw_ = (unsigned*)(args.ws + WS_CTL) + 20000; const unsigned mn = 0xFFFFFFFFu - __hip_atomic_load(cw_, __ATOMIC_RELAXED, __HIP_MEMORY_SCOPE_AGENT), mx = __hip_atomic_load(cw_ + 64, __ATOMIC_RELAXED, __HIP_MEMORY_SCOPE_AGENT); \
        const long long until = wall_clock64() + (long long)(mx - mn) * 4; while (wall_clock64() < until) __builtin_amdgcn_s_sleep(8); } } while (0)
#else
#define PROBE_SKEW_SPIN(p) do { } while (0)
#endif
#ifdef PROBE_SKEW
#define SKEW_RECORD(p) do { if ((p) == (PROBE_TIME) && tid_of(wave_s) == 0) { const unsigned el = (unsigned)(wall_clock64() - tph); unsigned* cw_ = (unsigned*)(args.ws + WS_CTL) + 20000; \
        atomicMax(cw_, 0xFFFFFFFFu - el); atomicMax(cw_ + 64, el); } } while (0)
#else
#define SKEW_RECORD(p) do { } while (0)
#endif
#ifndef PROBE_TIME_FULL
#define PROBE_TIME_FULL 0
#endif
#define SEAM(p) do { if (RUN(p) && RUN((p) + 1)) { SKEW_RECORD(p); if (!PROBE_TIME_FULL && bx == 0 && (p) == (PROBE_TIME)) { const long long w1 = wall_clock64(), until = w1 + (w1 - tph) * 4; while (wall_clock64() < until) __builtin_amdgcn_s_sleep(8); } \
        xcd_barrier(bar); \
        PROBE_SKEW_SPIN(p); \
        if (PROBE_TIME_FULL == 1 && bx == 0 && (p) == (PROBE_TIME)) { const long long w1 = wall_clock64(), until = w1 + (w1 - tph) * 4; while (wall_clock64() < until) __builtin_amdgcn_s_sleep(8); } \
        tph = wall_clock64(); } } while (0)
#else
#ifdef PROBE_DOUBLE_BAR
#define SEAM(p) do { if (RUN(p) && RUN((p) + 1)) { xcd_barrier(bar); xcd_barrier(bar); } } while (0)
#else
#define SEAM(p) do { if (RUN(p) && RUN((p) + 1)) xcd_barrier(bar); } while (0)
#endif
#endif

#define XN   ((bf16_t*)(w + WS_XN))
#define UH   ((bf16_t*)(w + WS_R + R_UH))
#define XR   ((bf16_t*)(w + WS_R + R_XR))
#define TMP  ((bf16_t*)(w + WS_R + R_TMP))
#define GG   ((bf16_t*)(w + WS_R + R_GG))
#define SGA  ((bf16_t*)(w + WS_R + R_SGA))
#define SGB  ((bf16_t*)(w + WS_R + R_SGB))
#define SBUF ((float*)(w + WS_R + R_SBUF))
#define YA   ((bf16_t*)(w + WS_R + R_YA))
#define YG   ((bf16_t*)(w + WS_R + R_YG))
#define YB   ((bf16_t*)(w + WS_R + R_YB))
#define ACT  ((bf16_t*)(w + WS_R + R_ACT))
#define EDGE ((float*)(w + WS_R + R_EDGE))
#define RSS  ((u64*)(w + WS_RSS))
#define LRUQ ((unsigned*)(w + WS_CTL) + CW_LRUQ)
#define PHASE_LOCALS unsigned z_ = 0u; asm volatile("" : "+s"(z_)); Ptrs Q; Q.a = (const __attribute__((address_space(4))) Args*)((const __attribute__((address_space(4))) char*)__builtin_amdgcn_kernarg_segment_ptr() + z_); \
    unsigned char* w = (unsigned char*)(GAS unsigned char*)Q.a->ws; float* Xl = (float*)(GAS float*)Q.a->out; (void)w; (void)Xl; \
    int bxl = bx, Gl = G; asm volatile("" : "+s"(bxl), "+s"(Gl)); const int ngwl = Gl * 8, ngtl = Gl * 512; (void)ngwl; (void)ngtl
    for (int rep = 0; rep < NREP(0); ++rep) if (EN(0) && RUN(0)) { PHASE_LOCALS;
        const int td = tid_of(wave_s), lane = td & 63, wave = WAVE_OF(td), gw = bxl * 8 + wave, gt = bxl * 512 + td;
#ifndef PROBE_PRO
#define PROBE_PRO 0
#endif
#ifdef PROBE_PRO_T
        long long tp0 = wall_clock64(), tp1, tp2, tp3;
#endif
        for (int r3 = 0; r3 < (PROBE_PRO == 3 ? 2 : 1); ++r3) input_phase(Q, XN, RSS, gw, ngwl, lane);
#ifdef PROBE_PRO_T
        tp1 = wall_clock64();
#endif
        for (int r2 = 0; r2 < (PROBE_PRO == 2 ? 2 : 1); ++r2) for (int it = bxl; it < DEPTH * SG; it += Gl) s5_prep_item(Q, w, it / SG, it % SG, (float*)lds, td);
#ifdef PROBE_PRO_T
        tp2 = wall_clock64();
#endif
        lru_prep(Q, w, gt, ngtl);
        float* scr = (float*)(lds + wave * 16384);
        for (int r1 = 0; r1 < (PROBE_PRO == 1 ? 2 : 1); ++r1) {
        transpose_all(Q.w_in(), D, INC, w, WL_IN, false, Q.norm1_g(), scr, lane, gw, ngwl);
        transpose_all(Q.s5_w_glu(), 1024, 1024, w, WL_GLU, false, nullptr, scr, lane, gw, ngwl);
        transpose_all(Q.w_proj_a(), 1024, D, w, WL_PA, false, nullptr, scr, lane, gw, ngwl);
        transpose_all(Q.w_proj_b(), 1024, D, w, WL_PB, false, nullptr, scr, lane, gw, ngwl);
        transpose_all(Q.w_out(), D, D, w, WL_OUT, false, nullptr, scr, lane, gw, ngwl);
        transpose_all(Q.ffn_w_up(), D, F2, w, WL_UP, true, Q.norm2_g(), scr, lane, gw, ngwl);
        transpose_all(Q.ffn_w_down(), FH, D, w, WL_DOWN, false, nullptr, scr, lane, gw, ngwl);
        }
#ifdef PROBE_PRO_T
        tp3 = wall_clock64();
        if (bxl == 0) { const long long dt_ = (PROBE_PRO_T == 1) ? tp1 - tp0 : (PROBE_PRO_T == 2) ? tp2 - tp1 : tp3 - tp2; const long long until = wall_clock64() + dt_ * 4; while (wall_clock64() < until) __builtin_amdgcn_s_sleep(8); }
#endif
        __syncthreads();
    }
    SEAM(0);

#pragma unroll 1
    for (int l = 0; l < DEPTH; ++l) {
        const int pb = 1 + l * NPH_LAYER;
#define wl (w + WS_W + (size_t)l * WL_STRIDE)
        for (int rep = 0; rep < NREP(1); ++rep) if (EN(1) && RUN(pb + 0)) { PHASE_LOCALS;
            pg8::Gemm g{XN, (const bf16_t*)(wl + WL_IN), D, D, D}; pg8::OrderMN S; S.init(T, INC, Gl, bxl); if (Gl == 256) S.iend = IN_FULL_ROUNDS;
#ifdef PROBE_HALFK
            if (rep == 0) g.K = D / 2;
#endif
            pg8::EpiIn E{UH, XR, GG, SGA, SGB, RSS + (size_t)(2 * l) * T, ldsl + SIDE_OFF};
#ifdef PROBE_STAGGER
            if (bxl & 1) { const long long until = wall_clock64() + (PROBE_STAGGER) * 100; while (wall_clock64() < until) __builtin_amdgcn_s_sleep(8); }
#endif
#ifdef PROBE_CLOCK
            long long c0 = clock64(), w0 = wall_clock64();
#endif
            pg8::gemm_phase(ldsl, g, S, E, wave_s);
#ifdef PROBE_CLOCK
            if (l == 1 && bxl == 0) { const long long c1 = clock64(), w1 = wall_clock64(); const long long ratio16 = (c1 - c0) * 16 / (w1 - w0);
              const long long until = w1 + ratio16 * 100; while (wall_clock64() < until) __builtin_amdgcn_s_sleep(8); }
#endif
        }
        SEAM(pb + 0);
        for (int rep = 0; rep < NREP(2); ++rep) if (EN(2) && RUN(pb + 1)) { PHASE_LOCALS;
            if (Gl == 256) { pg8::Gemm g{XN, (const bf16_t*)(wl + WL_IN), D, D, D}; pg8::OrderMN S; S.init(T, INC, Gl, bxl); S.i0 = IN_FULL_ROUNDS;
              pg8::EpiIn E{UH, XR, GG, SGA, SGB, RSS + (size_t)(2 * l) * T, ldsl + SIDE_OFF}; pg8::gemm_phase(ldsl, g, S, E, wave_s); }
            { pg8::Gemm g{UH, (const bf16_t*)(w + WS_S5 + (size_t)l * S5_STRIDE + S5_BT1), UHW, 512, 512}; pg8::OrderBatched<3, 1, NCR, 256, SG> S; if (Gl == 256) S.init(128, bxl >= 128 ? bxl - 128 : (1 << 20)); else S.init(Gl, bxl);
              pg8::EpiS1 E{SBUF}; pg8::gemm_phase(ldsl, g, S, E, wave_s);
              const int td = tid_of(wave_s); pg8::Unit uu;
#pragma unroll 1
              for (int i = 0; S.next(i, uu); ++i)
                  if (count_in_last((unsigned*)(w + WS_CTL) + CW_SCNT + (l * SG + uu.g) * 16, 1u, 3u, MISC, td))
                      for (int t = td; t < 5 * 2 * SP; t = (t >= 128 && t < 256) ? t + 384 : 640) { const int p = t & 63, d = (t >> 6) & 1, sq = t >> 7; s5_chain(Q, w, l, uu.g, d, p, sq == 0 ? 0 : 256 + 128 * (sq - 1), sq == 0 ? 256 : 128); } }
            { const int td = tid_of(wave_s), hb = bxl & 15;
              const int nproc = lru_phase<1>(Q, w, l, hb, LRUQ + ((l * 2 + 0) * 16 + hb) * 16 + rep * 8, lds, MISC, td);
              if (count_in_last((unsigned*)(w + WS_CTL) + CW_LCNT + (l * 16 + hb) * 16, (unsigned)nproc, (unsigned)NTC, MISC, td))
                  for (int t = td; t < 5 * 2 * 64; t = (t >= 128 && t < 256) ? t + 384 : 640) lru_chain(w, hb * 64 + (t & 63), (t >> 6) & 1, t >> 7); }
        }
        SEAM(pb + 1);
        for (int rep = 0; rep < NREP(4); ++rep) if (EN(4) && RUN(pb + 2)) { PHASE_LOCALS;
            { pg8::Gemm g{UH, (const bf16_t*)(w + WS_S5 + (size_t)l * S5_STRIDE + S5_BT2), UHW, UHW, UHW}; pg8::OrderBatched<3, 2, NCR, 512, SG> S; S.init(Gl, bxl);
              pg8::EpiS2 E{YG}; pg8::gemm_phase(ldsl, g, S, E, wave_s); }
            lru_phase<2>(Q, w, l, bxl & 15, LRUQ + ((l * 2 + 1) * 16 + (bxl & 15)) * 16 + rep * 8, lds, MISC, tid_of(wave_s));
        }
        SEAM(pb + 2);
        for (int rep = 0; rep < NREP(5); ++rep) if (EN(5) && RUN(pb + 3)) { PHASE_LOCALS;
            { pg8::Gemm g{YG, (const bf16_t*)(wl + WL_GLU), 1024, 1024, 1024}; pg8::OrderMN S; S.init(T, 1024, Gl, bxl); pg8::EpiMul<0> E{YA, YG, 1024}; pg8::gemm_phase(ldsl, g, S, E, wave_s); }
            { pg8::Gemm g{YB, (const bf16_t*)(wl + WL_PB), 1024, 1024, 1024}; pg8::OrderMN S; S.init(T, D, Gl, bxl); pg8::EpiMul<1> E{TMP, SGB, D}; pg8::gemm_phase(ldsl, g, S, E, wave_s); }
        }
        SEAM(pb + 3);
        if (EN(6) && RUN(pb + 4)) { PHASE_LOCALS; pg8::Gemm g{YA, (const bf16_t*)(wl + WL_PA), 1024, 1024, 1024}; pg8::OrderMN S; S.init(T, D, Gl, bxl); pg8::EpiMul<2> E{TMP, SGA, D}; pg8::gemm_phase(ldsl, g, S, E, wave_s); }
        SEAM(pb + 4);
        if (EN(7) && RUN(pb + 5)) { PHASE_LOCALS; pg8::Gemm g{TMP, (const bf16_t*)(wl + WL_OUT), D, D, D}; pg8::OrderMN S; S.init(T, D, Gl, bxl); pg8::EpiRes E{XN, RSS + (size_t)(2 * l + 1) * T}; pg8::gemm_phase(ldsl, g, S, E, wave_s); }
        SEAM(pb + 5);
        for (int rep = 0; rep < NREP(8); ++rep) if (EN(8) && RUN(pb + 6)) { PHASE_LOCALS;
            pg8::Gemm g{XN, (const bf16_t*)(wl + WL_UP), D, D, D}; pg8::OrderMN S; S.init(T, F2, Gl, bxl);
#ifdef PROBE_HALFK_UP
            if (rep == 0) g.K = D / 2;
#endif
            pg8::EpiUp E{ACT, EDGE, Q.ffn_conv_w() + (size_t)l * 3 * F2, RSS + (size_t)(2 * l + 1) * T, ldsl + SIDE_OFF, (LAS float*)(ldsl + XCH_OFF)};
            pg8::gemm_phase(ldsl, g, S, E, wave_s);
        }
        SEAM(pb + 6);
        if (EN(10) && RUN(pb + 7)) { PHASE_LOCALS; pg8::Gemm g{ACT, (const bf16_t*)(wl + WL_DOWN), FH, FH, FH}; pg8::OrderMN S; S.init(T, D, Gl, bxl); pg8::EpiRes E{XN, RSS + (size_t)(2 * l + 2) * T};
            { const int td = tid_of(wave_s); pg8::Unit uu; int lastpm = -1;
#pragma unroll
              for (int i = 0; i < 4; ++i) { const bool ok = S.next(i, uu); const int pmv = ok ? uu.pm : lastpm; if (pmv != lastpm) { fix_rows_of_panel(Q, w, l, pmv, td); lastpm = pmv; } }
              asm volatile("s_waitcnt vmcnt(0)" ::: "memory"); __syncthreads(); }
            pg8::gemm_phase(ldsl, g, S, E, wave_s); }
        SEAM(pb + 7);
    }
    if (EN(11) && RUN(NPHASE - 1)) { PHASE_LOCALS; const int td = tid_of(wave_s); final_norm_phase(Xl, XN, RSS + (size_t)8 * T, Q.final_g(), bxl * 8 + WAVE_OF(td), ngwl, td & 63); }
#ifdef PROBE_TIME
    if (bx == 0 && (PROBE_TIME) == NPHASE - 1) { const long long w1 = wall_clock64(), until = w1 + (w1 - tph) * 4; while (wall_clock64() < until) __builtin_amdgcn_s_sleep(8); }
#endif
#undef RUN
#undef SEAM
}

extern "C" void kernel_launch(void* const* d_in, const int* in_sizes, int n_in, void* d_out, int out_size, void* d_ws, size_t ws_size, hipStream_t stream) {
    static int grid = 0;
    if (grid == 0) {
        if (n_in != 28 || out_size != T * D || ws_size < WS_END) { fprintf(stderr, "kernel_launch: unexpected shapes: n_in %d out %d ws %zu (need %zu)\n", n_in, out_size, ws_size, (size_t)WS_END); grid = -1; return; }
        int dev = 0, cus = 0, per_cu = 0;
        if (hipGetDevice(&dev) != hipSuccess || hipDeviceGetAttribute(&cus, hipDeviceAttributeMultiprocessorCount, dev) != hipSuccess) { grid = -1; return; }
        if (hipFuncSetAttribute((const void*)fwd, hipFuncAttributeMaxDynamicSharedMemorySize, LDS_BYTES) != hipSuccess) { fprintf(stderr, "kernel_launch: hipFuncSetAttribute failed\n"); grid = -1; return; }
        if (hipOccupancyMaxActiveBlocksPerMultiprocessor(&per_cu, (const void*)fwd, 512, LDS_BYTES) != hipSuccess || per_cu < 1) { fprintf(stderr, "kernel_launch: occupancy query says %d\n", per_cu); }
        (void)hipGetLastError();
        grid = cus;
    }
    if (grid < 0) return;
    (void)hipMemsetAsync((char*)d_ws + WS_CTL, 0, CTL_BYTES, stream);
    Args a{};
    for (int i = 0; i < 28; ++i) a.in[i] = (const float*)d_in[i];
    a.out = (float*)d_out; a.ws = (unsigned char*)d_ws;
#if MK_ONE_LAUNCH
    a.ph_lo = 0; a.ph_hi = NPHASE;
    hipLaunchKernelGGL(fwd, dim3(grid), dim3(512), LDS_BYTES, stream, a);
#else
    for (int p = 0; p < NPHASE; ++p) { a.ph_lo = p; a.ph_hi = p + 1; hipLaunchKernelGGL(fwd, dim3(grid), dim3(512), LDS_BYTES, stream, a); }
#endif
}
```

```cpp
#include <hip/hip_runtime.h>
#include <cstdio>
#include <cstdint>

#ifndef MK_ONE_LAUNCH
#define MK_ONE_LAUNCH 1
#endif

#define LAS __attribute__((address_space(3)))
#define GAS __attribute__((address_space(1)))
typedef unsigned short bf16_t;
typedef short bf16x8 __attribute__((ext_vector_type(8)));
typedef float f32x4 __attribute__((ext_vector_type(4)));
typedef float f32x2 __attribute__((ext_vector_type(2)));
typedef unsigned u32x4 __attribute__((ext_vector_type(4)));
typedef unsigned u32x2 __attribute__((ext_vector_type(2)));

constexpr int D = 2048, T = 24576, DEPTH = 4, INC = 7168, FH = 6144, F2 = 12288;
constexpr int SG = 64, SP = 64, SH = 16, SL = 32;
constexpr int NCR = T / SL;
constexpr int UHW = SL * SH + 4 * SP;
constexpr int LT = 128, NTC = T / LT;
constexpr float EPS = 1e-6f;
constexpr int IN_FULL_ROUNDS = (T / 256) * (7168 / 256) / 256;
constexpr int NPH_LAYER = 8, NPHASE = 2 + DEPTH * NPH_LAYER;

constexpr size_t MiB = 1u << 20;
constexpr size_t WS_CTL = 0, CTL_BYTES = 3 * MiB;
constexpr size_t WS_RSS = 1 * MiB;
constexpr size_t WS_W = 4 * MiB;
constexpr size_t WL_IN = 0, WL_GLU = 28 * MiB, WL_PA = 30 * MiB, WL_PB = 34 * MiB, WL_OUT = 38 * MiB, WL_UP = 46 * MiB, WL_DOWN = 94 * MiB, WL_STRIDE = 118 * MiB;
constexpr size_t WS_S5 = WS_W + DEPTH * WL_STRIDE;
constexpr size_t S5_BT1 = 0, S5_BT2 = 16 * MiB, S5_STRIDE = 64 * MiB;
constexpr size_t WS_LRUW = WS_S5 + DEPTH * S5_STRIDE;
constexpr size_t LRUW_STRIDE = 512 * 1024;
constexpr size_t WS_C8V = 3 * MiB - 64 * 1024;
constexpr size_t WS_XN = WS_LRUW + 2 * MiB;
constexpr size_t WS_R = WS_XN + 96 * MiB;
constexpr size_t R_UH = 0, R_XR = 72 * MiB, R_TMP = 0  , R_GG = 120 * MiB, R_SGA = 168 * MiB, R_SGB = 264 * MiB, R_SBUF = 360 * MiB, R_YA = 360 * MiB  ,
                 R_YG = 408 * MiB, R_YB = 456 * MiB, R_LSUM = 504 * MiB, R_CIN = 508 * MiB, R_MIX_END = 510 * MiB;
constexpr size_t R_ACT = 0, R_EDGE = 288 * MiB, R_FFN_END = 307 * MiB;
constexpr size_t WS_END = WS_R + R_MIX_END;
static_assert(WS_RSS + (size_t)9 * T * 8 <= WS_C8V && WS_C8V + DEPTH * 2 * 1024 * 4 <= CTL_BYTES && CTL_BYTES <= WS_W, "control region");
static_assert((size_t)SG * NCR * UHW * 2 == 72 * MiB && (size_t)T * 1024 * 2 == 48 * MiB && (size_t)SG * NCR * 256 * 4 == 48 * MiB, "sizes");
static_assert((size_t)96 * 4 * 2 * FH * 4 <= 19 * MiB && R_FFN_END <= R_MIX_END, "ffn overlay");

constexpr int CW_BAR = 4096, CW_LRUQ = 16384, CW_SCNT = 24576, CW_LCNT = 28672;
constexpr int CW_LRUQ_DOC = 0;

constexpr int STAGE_BYTES = 131072, XCH_OFF = 131072, XCH_BYTES = 8192, MISC_OFF = XCH_OFF + XCH_BYTES, SIDE_OFF = MISC_OFF + 1024, SIDE_BYTES = 6144, LDS_BYTES = 155648;
static_assert(SIDE_OFF + 2 * SIDE_BYTES <= LDS_BYTES && LDS_BYTES <= 163840, "LDS map");

typedef __bf16 bf16x2_t __attribute__((ext_vector_type(2)));
__device__ __forceinline__ unsigned cvt_pk_bf16(float lo, float hi) { const f32x2 v = {lo, hi}; return __builtin_bit_cast(unsigned, __builtin_convertvector(v, bf16x2_t)); }
__device__ __forceinline__ float bf_lo(unsigned w) { return __uint_as_float(w << 16); }
__device__ __forceinline__ float bf_hi(unsigned w) { return __uint_as_float(w & 0xffff0000u); }
__device__ __forceinline__ float fast_sigmoid(float x) { return __builtin_amdgcn_rcpf(1.0f + __builtin_amdgcn_exp2f(x * -1.44269504f)); }
__device__ __forceinline__ float gelu_tanh(float x) { const float t = x * (-2.3022082f + -0.10294324f * (x * x)); return x * __builtin_amdgcn_rcpf(1.0f + __builtin_amdgcn_exp2f(t)); }
typedef unsigned long long u64;
constexpr float RSS_SCALE = 16777216.0f, RSS_INV = 1.0f / 16777216.0f / (float)D;
__device__ __forceinline__ float rss_mean(u64 q) { return ((float)(unsigned)(q >> 32) * 4294967296.0f + (float)(unsigned)q) * RSS_INV; }
__device__ __forceinline__ void sigmoid8(f32x4& a, f32x4& b) {
    f32x4 ta = a * -1.44269504f, tb = b * -1.44269504f;
#pragma unroll
    for (int j = 0; j < 4; ++j) { ta[j] = __builtin_amdgcn_exp2f(ta[j]); tb[j] = __builtin_amdgcn_exp2f(tb[j]); }
    ta = ta + 1.0f; tb = tb + 1.0f;
#pragma unroll
    for (int j = 0; j < 4; ++j) { a[j] = __builtin_amdgcn_rcpf(ta[j]); b[j] = __builtin_amdgcn_rcpf(tb[j]); }
}
__device__ __forceinline__ void gelu8(f32x4& a, f32x4& b) {
    f32x4 ta = a * (a * a * -0.10294324f + -2.3022082f), tb = b * (b * b * -0.10294324f + -2.3022082f);
#pragma unroll
    for (int j = 0; j < 4; ++j) { ta[j] = __builtin_amdgcn_exp2f(ta[j]); tb[j] = __builtin_amdgcn_exp2f(tb[j]); }
    ta = ta + 1.0f; tb = tb + 1.0f;
#pragma unroll
    for (int j = 0; j < 4; ++j) { ta[j] = __builtin_amdgcn_rcpf(ta[j]); tb[j] = __builtin_amdgcn_rcpf(tb[j]); }
    a = a * ta; b = b * tb;
}
__device__ __forceinline__ float wave_sum(float v) {
#pragma unroll
    for (int o = 1; o < 64; o <<= 1) v += __shfl_xor(v, o);
    return v;
}
__device__ __forceinline__ int opaque(int v) { asm volatile("" : "+v"(v)); return v; }
__device__ __forceinline__ int tid_of(int wave_s) { unsigned z = 0u; asm volatile("" : "+s"(z)); return wave_s * 64 + (int)__builtin_amdgcn_mbcnt_hi(~0u, __builtin_amdgcn_mbcnt_lo(~0u, z)); }
template <class Tp> __device__ __forceinline__ Tp* launder(Tp* p) { unsigned lo = (unsigned)(uintptr_t)p, hi = (unsigned)((uintptr_t)p >> 32); asm volatile("" : "+v"(lo), "+v"(hi));
    lo = __builtin_amdgcn_readfirstlane(lo); hi = __builtin_amdgcn_readfirstlane(hi); return (Tp*)(((uintptr_t)hi << 32) | lo); }
template <int CTRL> __device__ __forceinline__ float dppf(float x) { return __builtin_bit_cast(float, __builtin_amdgcn_update_dpp(0, __builtin_bit_cast(int, x), CTRL, 0xf, 0xf, false)); }

#define XB_TMO      128
#define XB_XCNT(j)  (256  + 64 * (j))
#define XB_XSUB(j)  (1280 + 64 * (j))
#define XB_XGEN(j)  (2304 + 64 * (j))
#define XB_TOP      3328
#define XB_TOPGEN   3392
#define XCD_BAR_WORDS 3456
#define XB_SPIN_CAP (1u << 20)
__device__ __forceinline__ unsigned xb_ld(unsigned* p)              { return __hip_atomic_load(p, __ATOMIC_RELAXED, __HIP_MEMORY_SCOPE_AGENT); }
__device__ __forceinline__ unsigned xb_add(unsigned* p, unsigned v) { return __hip_atomic_fetch_add(p, v, __ATOMIC_RELAXED, __HIP_MEMORY_SCOPE_AGENT); }
__device__ __forceinline__ unsigned xb_xcc_id() { return (unsigned)__builtin_amdgcn_s_getreg((3 << 11) | 20) & 0xFu; }
#define XB_SPIN(cond, bar) do { unsigned _sp = 0; while (cond) { __builtin_amdgcn_s_sleep(1); \
    if ((++_sp & 255u) == 0u) { if (xb_ld(&(bar)[XB_TMO])) break; if (_sp > XB_SPIN_CAP) { atomicAdd(&(bar)[XB_TMO], 1u); break; } } } } while (0)
struct XcdBarrier { unsigned* bar; unsigned x; volatile LAS unsigned* st; };
__device__ __forceinline__ XcdBarrier xcd_barrier_post(unsigned* bar, volatile LAS unsigned* st) {
    XcdBarrier b; b.bar = bar; b.x = xb_xcc_id(); b.st = st;
    if (threadIdx.x == 0) (void)xb_add(&bar[XB_XCNT(b.x)], 1u);
    return b;
}
__device__ __forceinline__ void xcd_barrier_complete(unsigned* bar, unsigned x, unsigned& nloc, unsigned& nx) {
    const unsigned G = gridDim.x * gridDim.y * gridDim.z;
    unsigned sum, cnt, mine, sp = 0u;
    for (;;) {
        sum = 0u; cnt = 0u; mine = 0u;
#pragma unroll
        for (unsigned j = 0; j < 16; ++j) { const unsigned c = xb_ld(&bar[XB_XCNT(j)]); sum += c; cnt += (c > 0u) ? 1u : 0u; mine = (j == x) ? c : mine; }
        if (sum == G) break;
        __builtin_amdgcn_s_sleep(1);
        if ((++sp & 255u) == 0u) { if (xb_ld(&bar[XB_TMO])) break; if (sp > XB_SPIN_CAP) { atomicAdd(&bar[XB_TMO], 1u); break; } }
    }
    nloc = mine > 0u ? mine : 1u; nx = cnt > 0u ? cnt : 1u;
}
__device__ __forceinline__ void xcd_barrier(const XcdBarrier& b) {
    asm volatile("s_waitcnt vmcnt(0)" ::: "memory");
    __syncthreads();
    if (threadIdx.x == 0) {
        unsigned* bar = b.bar;
        __builtin_amdgcn_s_waitcnt(0);
        unsigned nloc = b.st[0], nx = b.st[1];
        if (nloc == 0u) { xcd_barrier_complete(bar, b.x, nloc, nx); b.st[0] = nloc; b.st[1] = nx; }
        const unsigned old = xb_add(&bar[XB_XSUB(b.x)], 1u);
        const unsigned gen = old / nloc;
        if (old + 1u == (gen + 1u) * nloc) {
            __builtin_amdgcn_fence(__ATOMIC_RELEASE, "agent");
            asm volatile("s_waitcnt vmcnt(0)" ::: "memory");
            const unsigned og = xb_add(&bar[XB_TOP], 1u);
            const unsigned tg = og / nx;
            if (og + 1u == (tg + 1u) * nx) xb_add(&bar[XB_TOPGEN], 1u);
            else XB_SPIN(xb_ld(&bar[XB_TOPGEN]) == tg, bar);
            __builtin_amdgcn_fence(__ATOMIC_ACQUIRE, "agent");
            xb_add(&bar[XB_XGEN(b.x)], 1u);
            asm volatile("s_waitcnt vmcnt(0)" ::: "memory");
        } else {
            XB_SPIN(xb_ld(&bar[XB_XGEN(b.x)]) == gen, bar);
            __builtin_amdgcn_fence(__ATOMIC_ACQUIRE, "agent");
            asm volatile("s_waitcnt vmcnt(0)" ::: "memory");
        }
    }
    __syncthreads();
}

namespace pg8 {
constexpr int BM = 256, BK = 64, HALF = 128, HTB = HALF * BK * 2, NXCD = 8, WGM = 8;
__host__ __device__ __forceinline__ int lds_byte(int r, int c) { const int st = (r >> 4) * 2 + (c >> 5), rr = r & 15, cc = c & 31, ob = rr * 64 + cc * 2; return st * 1024 + (ob ^ (((ob >> 9) & 1) << 5)); }
__host__ __device__ __forceinline__ void stage_rc(int b, int& R, int& C) { const int st = b / 1024, sb = b % 1024, swz = sb ^ (((sb >> 9) & 1) << 5); R = (st >> 1) * 16 + swz / 64; C = (st & 1) * 32 + (swz % 64) / 2; }
__host__ __device__ __forceinline__ int perm32(int rho) { const int n = rho >> 4, i = rho & 15; return 8 * (i >> 2) + 4 * n + (i & 3); }

struct Unit { int arow, brow, pm, pn, g; };
struct Gemm { const bf16_t* A; const bf16_t* Bt; int lda, ldb, K; };

struct OrderMN {
    int nM, nN, nwg, G, c, i0, iend;
    __device__ __forceinline__ void init(int M, int N, int G_, int c_) { nM = M / BM; nN = N / BM; nwg = nM * nN; G = G_; c = c_; i0 = 0; iend = 0x7fffffff; }
    __device__ __forceinline__ bool next(int i, Unit& u) const {
        i += i0; if (i >= iend) return false;
        const long L = (long)i * G + c; if (L >= nwg) return false;
        int wgid = (int)L; { const int q = nwg / NXCD, r = nwg % NXCD, xcd = wgid % NXCD, off = wgid / NXCD; wgid = (xcd < r ? xcd * (q + 1) : r * (q + 1) + (xcd - r) * q) + off; }
        const int nig = WGM * nN, gid = wgid / nig, fm = gid * WGM, gsz = (nM - fm) < WGM ? (nM - fm) : WGM;
        u.pm = fm + ((wgid % nig) % gsz); u.pn = (wgid % nig) / gsz; u.g = 0; u.arow = u.pm * BM; u.brow = u.pn * BM; return true;
    }
};
template <int NM, int NN, int AR, int BR, int NG> struct OrderBatched {
    int G, c;
    __device__ __forceinline__ void init(int G_, int c_) { G = G_; c = c_; }
    __device__ __forceinline__ bool next(int i, Unit& u) const {
        const int L = i * G + c; if (L >= NG * NM * NN) return false;
        const int g = L / (NM * NN), r = L % (NM * NN); u.g = g; u.pm = r % NM; u.pn = r / NM; u.arow = g * AR + u.pm * BM; u.brow = g * BR + u.pn * BM; return true;
    }
};

template <class Epi, class Sched>
__device__ __forceinline__ void gemm_phase(LAS unsigned char* lds, const Gemm g, const Sched& S, const Epi& E, int wave_s) {
    const int tid = tid_of(wave_s), wid = __builtin_amdgcn_readfirstlane(tid >> 6), lane = tid & 63, wr = wid >> 2, wc = wid & 3, fr = lane & 15, fq = lane >> 4;
    const int K = g.K, nt = K / BK;
    unsigned voffA[2], voffB[2];
#pragma unroll
    for (int i = 0; i < 2; ++i) { int R, C; stage_rc(tid * 16 + i * 8192, R, C); const int Rb = Epi::PERM ? ((R & ~31) + perm32(R & 31)) : R;
        voffA[i] = (unsigned)(R * g.lda + C) * 2u; voffB[i] = (unsigned)(Rb * g.ldb + C) * 2u; }
    const size_t kstep = (size_t)(BK * 2);
    const size_t hstepA = (size_t)HALF * g.lda * 2, hstepB = (size_t)HALF * g.ldb * 2;
    const size_t rstepA = (size_t)g.lda * 2, rstepB = (size_t)g.ldb * 2;
    const unsigned ldsw = (unsigned)wid * 1024u;
    const int aoff = lds_byte(wr * 64 + fr, fq * 8), boff = lds_byte(wc * 32 + fr, fq * 8);
#define PG8_SA(b, h) (((b) * 2 + (h)) * HTB)
#define PG8_SB(b, h) ((4 + (b) * 2 + (h)) * HTB)
    const unsigned ldsb = (unsigned)(unsigned long)lds + ldsw;
#define PG8_STAGE(bufoff, gbase, voff) do { unsigned keep_; \
        asm volatile("s_mov_b32 %0, m0\n\ts_mov_b32 m0, %3\n\ts_nop 0\n\tglobal_load_lds_dwordx4 %1, %5\n\ts_mov_b32 m0, %4\n\ts_nop 0\n\tglobal_load_lds_dwordx4 %2, %5\n\ts_mov_b32 m0, %0" \
            : "=&s"(keep_) : "v"((voff)[0]), "v"((voff)[1]), "s"(ldsb + (unsigned)(bufoff)), "s"(ldsb + (unsigned)(bufoff) + 8192u), "s"((const char*)(gbase)) : "memory"); } while (0)
#define PG8_LDA(dst, b, h) do { _Pragma("unroll") for (int m = 0; m < 4; ++m) _Pragma("unroll") for (int k = 0; k < 2; ++k) dst[m][k] = *(const LAS bf16x8*)(lds + PG8_SA(b, h) + aoff + m * 2048 + k * 1024); } while (0)
#define PG8_LDB(dst, b, h) do { _Pragma("unroll") for (int n = 0; n < 2; ++n) _Pragma("unroll") for (int k = 0; k < 2; ++k) dst[n][k] = *(const LAS bf16x8*)(lds + PG8_SB(b, h) + boff + n * 2048 + k * 1024); } while (0)
#define PG8_MMA(ai, bj, At, Bt) do { __builtin_amdgcn_s_setprio(1); _Pragma("unroll") for (int m = 0; m < 4; ++m) _Pragma("unroll") for (int n = 0; n < 2; ++n) _Pragma("unroll") for (int k = 0; k < 2; ++k) \
        acc[ai][bj][m][n] = __builtin_amdgcn_mfma_f32_16x16x32_bf16(Bt[n][k], At[m][k], acc[ai][bj][m][n], 0, 0, 0); __builtin_amdgcn_s_setprio(0); } while (0)
#define PG8_WAIT_V(n) asm volatile("s_waitcnt vmcnt(" #n ")" ::: "memory")
#define PG8_WAIT_L(n) asm volatile("s_waitcnt lgkmcnt(" #n ")" ::: "memory")
#define PG8_BAR __builtin_amdgcn_s_barrier()
#define PG8_SCHED __builtin_amdgcn_sched_barrier(0)
    Unit cur, nxt; int ui = 0;
    if (!S.next(0, cur)) return;
    f32x4 acc[2][2][4][2];
#pragma unroll
    for (int a = 0; a < 2; ++a)
#pragma unroll
        for (int b = 0; b < 2; ++b)
#pragma unroll
            for (int m = 0; m < 4; ++m)
#pragma unroll
                for (int n = 0; n < 2; ++n) acc[a][b][m][n] = (f32x4){0.f, 0.f, 0.f, 0.f};
    bf16x8 At[4][2], B0[2][2], B1[2][2];
    const char* cA = (const char*)g.A + (size_t)cur.arow * rstepA; const char* cB = (const char*)g.Bt + (size_t)cur.brow * rstepB;
    int par = 0;
    E.prefetch(cur, wid, lane, par);
    PG8_STAGE(PG8_SB(0, 0), cB, voffB); PG8_STAGE(PG8_SB(0, 1), cB + hstepB, voffB); PG8_STAGE(PG8_SA(0, 0), cA, voffA); PG8_STAGE(PG8_SA(0, 1), cA + hstepA, voffA);
    if (wr == 1) PG8_BAR;
    PG8_WAIT_V(2); PG8_BAR;
    PG8_STAGE(PG8_SB(1, 0), cB + kstep, voffB); PG8_STAGE(PG8_SA(1, 0), cA + kstep, voffA); PG8_STAGE(PG8_SB(1, 1), cB + hstepB + kstep, voffB);
    PG8_WAIT_V(6); PG8_BAR;
    for (;;) {
        const bool has_next = S.next(ui + 1, nxt);
        const char* nA = has_next ? (const char*)g.A + (size_t)nxt.arow * rstepA : cA; const char* nB = has_next ? (const char*)g.Bt + (size_t)nxt.brow * rstepB : cB;
        for (int t = 0; t < nt; t += 2) {
            const bool last = (t == nt - 2);
            const char* a1 = cA + (size_t)(t + 1) * kstep;
            const char* a2 = last ? nA : cA + (size_t)(t + 2) * kstep; const char* b2 = last ? nB : cB + (size_t)(t + 2) * kstep;
            const char* a3 = a2 + kstep; const char* b3 = b2 + kstep;
            PG8_LDB(B0, 0, 0); PG8_LDB(B1, 0, 1); PG8_SCHED; PG8_LDA(At, 0, 0); PG8_STAGE(PG8_SA(1, 1), a1 + hstepA, voffA);
            PG8_WAIT_V(8); PG8_WAIT_L(0); PG8_BAR; PG8_MMA(0, 0, At, B0); PG8_MMA(0, 1, At, B1); PG8_BAR; PG8_SCHED;
            PG8_LDA(At, 0, 1); PG8_STAGE(PG8_SB(0, 0), b2, voffB); PG8_STAGE(PG8_SB(0, 1), b2 + hstepB, voffB); PG8_STAGE(PG8_SA(0, 0), a2, voffA);
            PG8_WAIT_V(8); PG8_WAIT_L(0); PG8_BAR; PG8_MMA(1, 0, At, B0); PG8_MMA(1, 1, At, B1); PG8_BAR; PG8_SCHED;
            PG8_LDB(B0, 1, 0); PG8_LDB(B1, 1, 1); PG8_SCHED; PG8_LDA(At, 1, 0); PG8_STAGE(PG8_SA(0, 1), a2 + hstepA, voffA);
            PG8_WAIT_V(8); PG8_WAIT_L(0); PG8_BAR; PG8_MMA(0, 0, At, B0); PG8_MMA(0, 1, At, B1); PG8_BAR; PG8_SCHED;
            PG8_LDA(At, 1, 1); PG8_STAGE(PG8_SB(1, 0), b3, voffB); PG8_STAGE(PG8_SB(1, 1), b3 + hstepB, voffB); PG8_STAGE(PG8_SA(1, 0), a3, voffA);
            PG8_WAIT_V(8); PG8_WAIT_L(0); PG8_BAR; PG8_MMA(1, 0, At, B0); PG8_MMA(1, 1, At, B1); PG8_BAR; PG8_SCHED;
        }
        if (wr == 0) PG8_BAR;
        { unsigned z = 0u; asm volatile("" : "+s"(z)); const int ln = (int)__builtin_amdgcn_mbcnt_hi(~0u, __builtin_amdgcn_mbcnt_lo(~0u, z)); int wr_e = wr, wc_e = wc; asm volatile("" : "+s"(wr_e), "+s"(wc_e)); E(acc, cur, wr_e, wc_e, ln & 15, ln >> 4, par);
#ifdef PROBE_EPI2
          if (Epi::PROBE_ID == PROBE_EPI2) E(acc, cur, wr_e, wc_e, ln & 15, ln >> 4, par | 2);
#endif
          if (has_next) E.prefetch(nxt, wr_e * 4 + wc_e, ln, par ^ 1); }
        par ^= 1;
        if (!has_next) break;
#pragma unroll
        for (int a = 0; a < 2; ++a)
#pragma unroll
            for (int b = 0; b < 2; ++b)
#pragma unroll
                for (int m = 0; m < 4; ++m)
#pragma unroll
                    for (int n = 0; n < 2; ++n) acc[a][b][m][n] = (f32x4){0.f, 0.f, 0.f, 0.f};
        cur = nxt; cA = nA; cB = nB; ++ui;
        if (wr == 1) PG8_BAR;
    }
    PG8_WAIT_V(0);
    PG8_BAR;
#undef PG8_SA
#undef PG8_SB
#undef PG8_STAGE
#undef PG8_LDA
#undef PG8_LDB
#undef PG8_MMA
#undef PG8_WAIT_V
#undef PG8_WAIT_L
#undef PG8_BAR
#undef PG8_SCHED
}

typedef f32x4 Acc[2][2][4][2];
__device__ __forceinline__ u32x4 pack8(const f32x4 a, const f32x4 b) { u32x4 w; w.x = cvt_pk_bf16(a[0], a[1]); w.y = cvt_pk_bf16(a[2], a[3]); w.z = cvt_pk_bf16(b[0], b[1]); w.w = cvt_pk_bf16(b[2], b[3]); return w; }
__device__ __forceinline__ void unpack8(const u32x4 w, f32x4& a, f32x4& b) { a = (f32x4){bf_lo(w.x), bf_hi(w.x), bf_lo(w.y), bf_hi(w.y)}; b = (f32x4){bf_lo(w.z), bf_hi(w.z), bf_lo(w.w), bf_hi(w.w)}; }
__device__ __forceinline__ unsigned pack4_u8(const f32x4 a) {
    const f32x4 q = a * 255.0f + 8388608.0f;
    const unsigned p01 = __builtin_amdgcn_perm(__float_as_uint(q[1]), __float_as_uint(q[0]), 0x0c0c0400u), p23 = __builtin_amdgcn_perm(__float_as_uint(q[3]), __float_as_uint(q[2]), 0x0c0c0400u);
    return __builtin_amdgcn_perm(p23, p01, 0x05040100u);
}
__device__ __forceinline__ void unpack8_u8(const u32x2 w, f32x4& a, f32x4& b) {
    a = (f32x4){(float)(w.x & 0xffu), (float)((w.x >> 8) & 0xffu), (float)((w.x >> 16) & 0xffu), (float)(w.x >> 24)};
    b = (f32x4){(float)(w.y & 0xffu), (float)((w.y >> 8) & 0xffu), (float)((w.y >> 16) & 0xffu), (float)(w.y >> 24)};
}

struct EpiIn {
    static constexpr int PROBE_ID = 1;
    static constexpr bool PERM = true;
    bf16_t *UH, *XR, *GG, *SGA, *SGB; const u64* RS; LAS unsigned char* side;
    __device__ __forceinline__ void prefetch(const Unit& u, int wid, int lane, int par) const {
        if (wid < 2) __builtin_amdgcn_global_load_lds((const unsigned*)(RS + u.pm * BM + wid * 128 + lane * 2), (LAS unsigned*)(side + par * SIDE_BYTES + wid * 1024), 16, 0, 0);
    }
    template <int KIND> __device__ __forceinline__ void body(Acc& acc, const float (&rs)[2][4], int row0, int cb, bf16_t* base, int ld, int coff) const {
#pragma unroll
        for (int ai = 0; ai < 2; ++ai)
#pragma unroll
            for (int m = 0; m < 4; ++m) { const int r = row0 + ai * HALF + m * 16;
#pragma unroll
                for (int bj = 0; bj < 2; ++bj) { f32x4 v0 = acc[ai][bj][m][0] * rs[ai][m], v1 = acc[ai][bj][m][1] * rs[ai][m];
                    if (KIND == 2) gelu8(v0, v1); else if (KIND == 3) sigmoid8(v0, v1);
                    if (KIND == 3) { u32x2 w8; w8.x = pack4_u8(v0); w8.y = pack4_u8(v1); *(u32x2*)((unsigned char*)base + (size_t)r * ld + coff + bj * HALF) = w8; continue; }
                    const u32x4 w = pack8(v0, v1);
                    if (KIND == 0) { const int c = cb + bj * HALF, gg = c >> 4; *(u32x4*)(UH + ((size_t)(gg * NCR + (r >> 5)) * UHW + (r & 31) * 16 + (c & 15))) = w; }
                    else *(u32x4*)(base + (size_t)r * ld + coff + bj * HALF) = w; } }
    }
    __device__ __forceinline__ void operator()(Acc& acc, const Unit& u, int wr, int wc, int fr, int fq, int par) const {
        par &= 1;
        const int pn = u.pn, row0 = u.pm * BM + wr * 64 + fr, cb = pn * BM + wc * 32 + 8 * fq;
        float rs[2][4];
#pragma unroll
        for (int ai = 0; ai < 2; ++ai)
#pragma unroll
            for (int m = 0; m < 4; ++m) rs[ai][m] = __builtin_amdgcn_rsqf(rss_mean(*(const LAS u64*)(side + par * SIDE_BYTES + (wr * 64 + fr + ai * HALF + m * 16) * 8)) + EPS);
        if (pn < 4) body<0>(acc, rs, row0, cb, UH, 0, 0);
        else if (pn < 8) body<1>(acc, rs, row0, cb, XR, 1024, cb - 1024);
        else if (pn < 12) body<2>(acc, rs, row0, cb, GG, 1024, cb - 2048);
        else if (pn < 20) body<3>(acc, rs, row0, cb, SGA, 2048, cb - 3072);
        else body<3>(acc, rs, row0, cb, SGB, 2048, cb - 5120);
    }
};
struct EpiS1 {
    __device__ __forceinline__ void prefetch(const Unit&, int, int, int) const {}
    static constexpr int PROBE_ID = 2;
    static constexpr bool PERM = false;
    float* C;
    __device__ __forceinline__ void operator()(Acc& acc, const Unit& u, int wr, int wc, int fr, int fq, int par) const {
        const int row0 = u.arow + wr * 64 + fr, col0 = wc * 32 + 4 * fq;
#pragma unroll
        for (int ai = 0; ai < 2; ++ai)
#pragma unroll
            for (int m = 0; m < 4; ++m) { float* rowp = C + (size_t)(row0 + ai * HALF + m * 16) * 256 + col0;
#pragma unroll
                for (int bj = 0; bj < 2; ++bj)
#pragma unroll
                    for (int n = 0; n < 2; ++n) *(f32x4*)(rowp + bj * HALF + n * 16) = acc[ai][bj][m][n]; }
    }
};
struct EpiS2 {
    __device__ __forceinline__ void prefetch(const Unit&, int, int, int) const {}
    static constexpr int PROBE_ID = 3;
    static constexpr bool PERM = true;
    bf16_t* YG;
    __device__ __forceinline__ void operator()(Acc& acc, const Unit& u, int wr, int wc, int fr, int fq, int par) const {
        const int cr0 = u.pm * BM + wr * 64 + fr, nb = u.pn * BM + wc * 32 + 8 * fq;
#pragma unroll
        for (int ai = 0; ai < 2; ++ai)
#pragma unroll
            for (int m = 0; m < 4; ++m) { const int cr = cr0 + ai * HALF + m * 16;
#pragma unroll
                for (int bj = 0; bj < 2; ++bj) { f32x4 v0 = acc[ai][bj][m][0], v1 = acc[ai][bj][m][1];
                    gelu8(v0, v1);
                    const int n = nb + bj * HALF, t = n >> 4, i0 = n & 15;
                    *(u32x4*)(YG + (size_t)(cr * SL + t) * 1024 + u.g * 16 + i0) = pack8(v0, v1); } }
    }
};
template <int MODE> struct EpiMul {
    __device__ __forceinline__ void prefetch(const Unit&, int, int, int) const {}
    static constexpr int PROBE_ID = 10 + MODE;
    static constexpr bool PERM = true;
    bf16_t* O; const bf16_t* X1; int ld;
    __device__ __forceinline__ void operator()(Acc& acc, const Unit& u, int wr, int wc, int fr, int fq, int par) const {
        const int row0 = u.pm * BM + wr * 64 + fr, col0 = u.pn * BM + wc * 32 + 8 * fq;
        constexpr int MB = (MODE == 2) ? 2 : 4;
#pragma unroll
        for (int ai = 0; ai < 2; ++ai)
#pragma unroll
            for (int mb = 0; mb < 4; mb += MB) {
                u32x4 xv[MB][2], ov[MB][2];
#pragma unroll
                for (int mm = 0; mm < MB; ++mm)
#pragma unroll
                    for (int bj = 0; bj < 2; ++bj) { const size_t ro = (size_t)(row0 + ai * HALF + (mb + mm) * 16) * ld + col0 + bj * HALF;
                        if (MODE == 0) xv[mm][bj] = *(const u32x4*)(X1 + ro); else { const u32x2 g8 = *(const u32x2*)((const unsigned char*)X1 + ro); xv[mm][bj].x = g8.x; xv[mm][bj].y = g8.y; }
                        if (MODE == 2) ov[mm][bj] = *(const u32x4*)(O + ro); }
#pragma unroll
                for (int mm = 0; mm < MB; ++mm) { const int m = mb + mm; const size_t ro = (size_t)(row0 + ai * HALF + m * 16) * ld + col0;
#pragma unroll
                    for (int bj = 0; bj < 2; ++bj) { f32x4 v0 = acc[ai][bj][m][0], v1 = acc[ai][bj][m][1], x0, x1;
                        if (MODE == 0) { unpack8(xv[mm][bj], x0, x1); sigmoid8(v0, v1); }
                        else { u32x2 g8; g8.x = xv[mm][bj].x; g8.y = xv[mm][bj].y; unpack8_u8(g8, x0, x1); v0 = v0 * (1.0f / 255.0f); v1 = v1 * (1.0f / 255.0f); }
                        v0 = v0 * x0; v1 = v1 * x1;
                        if (MODE == 2) { f32x4 t0, t1; unpack8(ov[mm][bj], t0, t1); v0 = v0 + t0; v1 = v1 + t1; }
                        *(u32x4*)(O + ro + bj * HALF) = pack8(v0, v1); } }
            }
    }
};
struct EpiRes {
    __device__ __forceinline__ void prefetch(const Unit&, int, int, int) const {}
    static constexpr int PROBE_ID = 5;
    static constexpr bool PERM = true;
    bf16_t* XB; u64* RS;
    __device__ __forceinline__ void operator()(Acc& acc, const Unit& u, int wr, int wc, int fr, int fq, int par) const {
        const int row0 = u.pm * BM + wr * 64 + fr, col0 = u.pn * BM + wc * 32 + 8 * fq;
#pragma unroll
        for (int ai = 0; ai < 2; ++ai) {
            u32x4 old[4][2];
#pragma unroll
            for (int m = 0; m < 4; ++m)
#pragma unroll
                for (int bj = 0; bj < 2; ++bj) old[m][bj] = *(const u32x4*)(XB + (size_t)(row0 + ai * HALF + m * 16) * D + col0 + bj * HALF);
#pragma unroll
            for (int m = 0; m < 4; ++m) { const int r = row0 + ai * HALF + m * 16; const size_t ro = (size_t)r * D + col0; float ss = 0.f;
#pragma unroll
                for (int bj = 0; bj < 2; ++bj) { f32x4 x0, x1; unpack8(old[m][bj], x0, x1); const f32x4 v0 = x0 + acc[ai][bj][m][0], v1 = x1 + acc[ai][bj][m][1];
                    ss += (v0[0] * v0[0] + v0[1] * v0[1]) + (v0[2] * v0[2] + v0[3] * v0[3]) + (v1[0] * v1[0] + v1[1] * v1[1]) + (v1[2] * v1[2] + v1[3] * v1[3]);
                    *(u32x4*)(XB + ro + bj * HALF) = pack8(v0, v1); }
                ss += __shfl_xor(ss, 16); ss += __shfl_xor(ss, 32);
                if (fq == 0) (void)__hip_atomic_fetch_add(RS + r, (u64)(ss * RSS_SCALE), __ATOMIC_RELAXED, __HIP_MEMORY_SCOPE_AGENT); }
        }
    }
};
struct EpiUp {
    static constexpr int PROBE_ID = 6;
    static constexpr bool PERM = true;
    bf16_t* ACT; float* EDGE; const float* cw; const u64* RS; LAS unsigned char* side;
    __device__ __forceinline__ void prefetch(const Unit& u, int wid, int lane, int par) const {
        if (wid < 2) __builtin_amdgcn_global_load_lds((const unsigned*)(RS + u.pm * BM + wid * 128 + lane * 2), (LAS unsigned*)(side + par * SIDE_BYTES + wid * 1024), 16, 0, 0);
        else if (wid < 5) __builtin_amdgcn_global_load_lds((const unsigned*)(cw + (size_t)(wid - 2) * F2 + (lane >> 5) * FH + u.pn * HALF + (lane & 31) * 4), (LAS unsigned*)(side + par * SIDE_BYTES + 2048 + (wid - 2) * 1024), 16, 0, 0);
    }
    LAS float* xch;
    __device__ __forceinline__ void operator()(Acc& acc, const Unit& u, int wr, int wc, int fr, int fq, int par) const {
        const int wid = wr * 4 + wc, pw = (1 - wr) * 4 + wc;
        const int gc0 = u.pn * HALF + wc * 32 + 8 * fq;
        const bool second = (par & 2) != 0; par &= 1;
        if (!second)
#pragma unroll
        for (int ai = 0; ai < 2; ++ai)
#pragma unroll
            for (int m = 0; m < 4; ++m) { const float rsv = __builtin_amdgcn_rsqf(rss_mean(*(const LAS u64*)(side + par * SIDE_BYTES + (ai * HALF + wr * 64 + m * 16 + fr) * 8)) + EPS);
#pragma unroll
                for (int bj = 0; bj < 2; ++bj) { acc[ai][bj][m][0] = acc[ai][bj][m][0] * rsv; acc[ai][bj][m][1] = acc[ai][bj][m][1] * rsv; } }
#pragma unroll
        for (int ai = 0; ai < 2; ++ai) {
            if (fr == 0) { LAS f32x4* p = (LAS f32x4*)(xch + (((wid * 2 + ai) * 2 + 0) * 4 + fq) * 16);
                p[0] = acc[ai][0][0][0]; p[1] = acc[ai][0][0][1]; p[2] = acc[ai][1][0][0]; p[3] = acc[ai][1][0][1]; }
            if (fr == 15) { LAS f32x4* p = (LAS f32x4*)(xch + (((wid * 2 + ai) * 2 + 1) * 4 + fq) * 16);
                p[0] = acc[ai][0][3][0]; p[1] = acc[ai][0][3][1]; p[2] = acc[ai][1][3][0]; p[3] = acc[ai][1][3][1]; }
        }
        {
            float* eb = EDGE + (size_t)u.pm * 4 * 2 * FH + gc0;
            if (wr == 0 && fr < 2) {
#pragma unroll
                for (int bj = 0; bj < 2; ++bj) { float* p = eb + (size_t)(fr * 2 + bj) * FH; *(f32x4*)p = acc[0][bj][0][0]; *(f32x4*)(p + 4) = acc[0][bj][0][1]; } }
            if (wr == 1 && fr >= 14) {
#pragma unroll
                for (int bj = 0; bj < 2; ++bj) { float* p = eb + (size_t)((fr - 12) * 2 + bj) * FH; *(f32x4*)p = acc[1][bj][3][0]; *(f32x4*)(p + 4) = acc[1][bj][3][1]; } }
        }
        unsigned wpk[3][2][4];
#pragma unroll
        for (int k = 0; k < 3; ++k)
#pragma unroll
            for (int bj = 0; bj < 2; ++bj) { const LAS float* p = (const LAS float*)(side + par * SIDE_BYTES + 2048 + k * 1024 + bj * 512) + wc * 32 + 8 * fq; const f32x4 a = *(const LAS f32x4*)p, b = *(const LAS f32x4*)(p + 4);
                wpk[k][bj][0] = cvt_pk_bf16(a[0], a[1]); wpk[k][bj][1] = cvt_pk_bf16(a[2], a[3]); wpk[k][bj][2] = cvt_pk_bf16(b[0], b[1]); wpk[k][bj][3] = cvt_pk_bf16(b[2], b[3]); }
        asm volatile("s_waitcnt lgkmcnt(0)" ::: "memory"); __builtin_amdgcn_s_barrier(); asm volatile("" ::: "memory");
        const unsigned long long m15 = __builtin_amdgcn_ballot_w64(fr == 15), m00 = __builtin_amdgcn_ballot_w64(fr == 0);
        u32x2 keep[2][4];
#pragma unroll
        for (int n = 0; n < 2; ++n) {
            f32x4 wv[3][2];
#pragma unroll
            for (int k = 0; k < 3; ++k)
#pragma unroll
                for (int bj = 0; bj < 2; ++bj) wv[k][bj] = (f32x4){bf_lo(wpk[k][bj][2 * n]), bf_hi(wpk[k][bj][2 * n]), bf_lo(wpk[k][bj][2 * n + 1]), bf_hi(wpk[k][bj][2 * n + 1])};
#pragma unroll
            for (int ai = 0; ai < 2; ++ai)
#pragma unroll
                for (int m = 0; m < 4; ++m) {
                    const bool up_out = (wr == 0 && ai == 0), dn_out = (wr == 1 && ai == 1);
                    const LAS f32x4* pu = (const LAS f32x4*)(xch + (((pw * 2 + ((wr == 0) ? 0 : ai)) * 2 + 1) * 4 + fq) * 16);
                    const LAS f32x4* pd = (const LAS f32x4*)(xch + (((pw * 2 + ((wr == 0) ? ai : 1)) * 2 + 0) * 4 + fq) * 16);
                    f32x4 h[2];
#pragma unroll
                    for (int bj = 0; bj < 2; ++bj) {
                        f32x4 upv, dnv; const f32x4 c = acc[ai][bj][m][n];
                        if (m > 0) upv = acc[ai][bj][m > 0 ? m - 1 : 0][n]; else upv = up_out ? (f32x4){0.f, 0.f, 0.f, 0.f} : pu[bj * 2 + n];
                        if (m < 3) dnv = acc[ai][bj][m < 3 ? m + 1 : 3][n]; else dnv = dn_out ? (f32x4){0.f, 0.f, 0.f, 0.f} : pd[bj * 2 + n];
                        float h0, h1, h2, h3, t0, t1, t2, t3;
                        asm volatile("v_cndmask_b32 %4, %8, %12, %24\n\tv_cndmask_b32 %5, %9, %13, %24\n\tv_cndmask_b32 %6, %10, %14, %24\n\tv_cndmask_b32 %7, %11, %15, %24\n\t"
                                     "v_mul_f32 %0, %16, %8\n\tv_mul_f32 %1, %17, %9\n\tv_mul_f32 %2, %18, %10\n\tv_mul_f32 %3, %19, %11\n\t"
                                     "v_fmac_f32_dpp %0, %4, %20 row_ror:1 row_mask:0xf bank_mask:0xf\n\tv_fmac_f32_dpp %1, %5, %21 row_ror:1 row_mask:0xf bank_mask:0xf\n\t"
                                     "v_fmac_f32_dpp %2, %6, %22 row_ror:1 row_mask:0xf bank_mask:0xf\n\tv_fmac_f32_dpp %3, %7, %23 row_ror:1 row_mask:0xf bank_mask:0xf"
                                     : "=&v"(h0), "=&v"(h1), "=&v"(h2), "=&v"(h3), "=&v"(t0), "=&v"(t1), "=&v"(t2), "=&v"(t3)
                                     : "v"(c[0]), "v"(c[1]), "v"(c[2]), "v"(c[3]), "v"(upv[0]), "v"(upv[1]), "v"(upv[2]), "v"(upv[3]),
                                       "v"(wv[1][bj][0]), "v"(wv[1][bj][1]), "v"(wv[1][bj][2]), "v"(wv[1][bj][3]), "v"(wv[0][bj][0]), "v"(wv[0][bj][1]), "v"(wv[0][bj][2]), "v"(wv[0][bj][3]), "s"(m15));
                        asm volatile("v_cndmask_b32 %4, %8, %12, %20\n\tv_cndmask_b32 %5, %9, %13, %20\n\tv_cndmask_b32 %6, %10, %14, %20\n\tv_cndmask_b32 %7, %11, %15, %20\n\t"
                                     "v_fmac_f32_dpp %0, %4, %16 row_ror:15 row_mask:0xf bank_mask:0xf\n\tv_fmac_f32_dpp %1, %5, %17 row_ror:15 row_mask:0xf bank_mask:0xf\n\t"
                                     "v_fmac_f32_dpp %2, %6, %18 row_ror:15 row_mask:0xf bank_mask:0xf\n\tv_fmac_f32_dpp %3, %7, %19 row_ror:15 row_mask:0xf bank_mask:0xf"
                                     : "+v"(h0), "+v"(h1), "+v"(h2), "+v"(h3), "=&v"(t0), "=&v"(t1), "=&v"(t2), "=&v"(t3)
                                     : "v"(c[0]), "v"(c[1]), "v"(c[2]), "v"(c[3]), "v"(dnv[0]), "v"(dnv[1]), "v"(dnv[2]), "v"(dnv[3]),
                                       "v"(wv[2][bj][0]), "v"(wv[2][bj][1]), "v"(wv[2][bj][2]), "v"(wv[2][bj][3]), "s"(m00));
                        h[bj] = (f32x4){h0, h1, h2, h3};
                    }
                    f32x4 o; { f32x4 tq = h[0] * (h[0] * h[0] * -0.10294324f + -2.3022082f);
#pragma unroll
                        for (int j = 0; j < 4; ++j) tq[j] = __builtin_amdgcn_exp2f(tq[j]);
                        tq = tq + 1.0f;
#pragma unroll
                        for (int j = 0; j < 4; ++j) tq[j] = __builtin_amdgcn_rcpf(tq[j]);
                        o = h[0] * tq * h[1]; }
                    u32x2 pk; pk.x = cvt_pk_bf16(o[0], o[1]); pk.y = cvt_pk_bf16(o[2], o[3]);
                    if (n == 0) keep[ai][m] = pk;
                    else { const int r = u.pm * BM + ai * HALF + wr * 64 + m * 16 + fr; u32x4 w4; w4.x = keep[ai][m].x; w4.y = keep[ai][m].y; w4.z = pk.x; w4.w = pk.y; *(u32x4*)(ACT + (size_t)r * FH + gc0) = w4; }
                }
        }
    }
};
}

struct Args {
    const float* in[28]; float* out; unsigned char* ws; int ph_lo, ph_hi;
};
struct Ptrs {
    const __attribute__((address_space(4))) Args* a;
    __device__ __forceinline__ const float* x_prompt() const { return (const float*)(GAS const float*)a->in[0]; }
    __device__ __forceinline__ const float* x_sample() const { return (const float*)(GAS const float*)a->in[1]; }
    __device__ __forceinline__ const float* norm1_g() const { return (const float*)(GAS const float*)a->in[2]; }
    __device__ __forceinline__ const float* w_in() const { return (const float*)(GAS const float*)a->in[3]; }
    __device__ __forceinline__ const float* s5_a_re() const { return (const float*)(GAS const float*)a->in[4]; }
    __device__ __forceinline__ const float* s5_a_im() const { return (const float*)(GAS const float*)a->in[5]; }
    __device__ __forceinline__ const float* s5_log_dt() const { return (const float*)(GAS const float*)a->in[6]; }
    __device__ __forceinline__ const float* s5_b_re() const { return (const float*)(GAS const float*)a->in[7]; }
    __device__ __forceinline__ const float* s5_b_im() const { return (const float*)(GAS const float*)a->in[8]; }
    __device__ __forceinline__ const float* s5_c_re() const { return (const float*)(GAS const float*)a->in[9]; }
    __device__ __forceinline__ const float* s5_c_im() const { return (const float*)(GAS const float*)a->in[10]; }
    __device__ __forceinline__ const float* s5_d() const { return (const float*)(GAS const float*)a->in[11]; }
    __device__ __forceinline__ const float* s5_w_glu() const { return (const float*)(GAS const float*)a->in[12]; }
    __device__ __forceinline__ const float* lru_conv_w() const { return (const float*)(GAS const float*)a->in[13]; }
    __device__ __forceinline__ const float* lru_conv_b() const { return (const float*)(GAS const float*)a->in[14]; }
    __device__ __forceinline__ const float* lru_w_a() const { return (const float*)(GAS const float*)a->in[15]; }
    __device__ __forceinline__ const float* lru_b_a() const { return (const float*)(GAS const float*)a->in[16]; }
    __device__ __forceinline__ const float* lru_w_x() const { return (const float*)(GAS const float*)a->in[17]; }
    __device__ __forceinline__ const float* lru_b_x() const { return (const float*)(GAS const float*)a->in[18]; }
    __device__ __forceinline__ const float* lru_lambda() const { return (const float*)(GAS const float*)a->in[19]; }
    __device__ __forceinline__ const float* w_proj_a() const { return (const float*)(GAS const float*)a->in[20]; }
    __device__ __forceinline__ const float* w_proj_b() const { return (const float*)(GAS const float*)a->in[21]; }
    __device__ __forceinline__ const float* w_out() const { return (const float*)(GAS const float*)a->in[22]; }
    __device__ __forceinline__ const float* norm2_g() const { return (const float*)(GAS const float*)a->in[23]; }
    __device__ __forceinline__ const float* ffn_w_up() const { return (const float*)(GAS const float*)a->in[24]; }
    __device__ __forceinline__ const float* ffn_conv_w() const { return (const float*)(GAS const float*)a->in[25]; }
    __device__ __forceinline__ const float* ffn_w_down() const { return (const float*)(GAS const float*)a->in[26]; }
    __device__ __forceinline__ const float* final_g() const { return (const float*)(GAS const float*)a->in[27]; }
};

struct TrIt { int l, k0, n0s, n0d; };
__device__ __forceinline__ TrIt tr_decode(int it, int per, int nblk, bool up_perm) {
    TrIt t; t.l = it / per; const int r = it % per, kb = r / nblk, nb = r % nblk; t.k0 = kb * 64; t.n0d = nb * 32; t.n0s = t.n0d;
    if (up_perm) { const int tile = t.n0d >> 8, wi = t.n0d & 255; t.n0s = (wi < 128) ? tile * 128 + wi : FH + tile * 128 + (wi - 128); }
    return t;
}
__device__ __forceinline__ void tr_load(const float* W, int K, int N, const TrIt& t, int lane, f32x4 (&v)[8]) {
    const int kr = lane >> 3, n4 = (lane & 7) * 4;
    const float* Wl = W + (size_t)t.l * K * N;
#pragma unroll
    for (int i = 0; i < 8; ++i) v[i] = *(const f32x4*)(Wl + (size_t)(t.k0 + 8 * i + kr) * N + t.n0s + n4);
}
__device__ __forceinline__ void tr_store(bf16_t* WT, int K, const TrIt& t, float* scr, const float* gl, int lane, const f32x4 (&v)[8]) {
    const int kr = lane >> 3, n4 = (lane & 7) * 4;
#pragma unroll
    for (int i = 0; i < 8; ++i) { const int kk = 8 * i + kr; const float gsc = gl ? gl[t.l * K + t.k0 + kk] : 1.0f; float* d = scr + kk * 33 + n4; d[0] = v[i][0] * gsc; d[1] = v[i][1] * gsc; d[2] = v[i][2] * gsc; d[3] = v[i][3] * gsc; }
    asm volatile("s_waitcnt lgkmcnt(0)" ::: "memory");
    const int c = lane & 7;
#pragma unroll
    for (int j = 0; j < 4; ++j) { const int n = (lane >> 3) + 8 * j; const float* sp = scr + (8 * c) * 33 + n;
        u32x4 o; o.x = cvt_pk_bf16(sp[0 * 33], sp[1 * 33]); o.y = cvt_pk_bf16(sp[2 * 33], sp[3 * 33]); o.z = cvt_pk_bf16(sp[4 * 33], sp[5 * 33]); o.w = cvt_pk_bf16(sp[6 * 33], sp[7 * 33]);
        *(u32x4*)(WT + (size_t)(t.n0d + n) * K + t.k0 + 8 * c) = o; }
    asm volatile("s_waitcnt lgkmcnt(0)" ::: "memory");
}
__device__ __forceinline__ void transpose_all(const float* W, int K, int N, unsigned char* ws, size_t woff, bool up_perm, const float* gain, float* scr, float* glds, int tid, int lane, int gw, int ngw) {
    const float* gl = nullptr;
    if (gain) { __syncthreads(); for (int i = tid; i < DEPTH * K; i += 512) glds[i] = gain[i]; __syncthreads(); gl = glds; }
    const int nblk = N / 32, per = (K / 64) * nblk, total = DEPTH * per;
    int it = gw;
    if (it >= total) return;
    f32x4 va[8], vb[8];
    TrIt ta = tr_decode(it, per, nblk, up_perm), tb;
    tr_load(W, K, N, ta, lane, va);
#pragma unroll 1
    while (true) {
        int nx = it + ngw; bool more = nx < total;
        tb = tr_decode(more ? nx : it, per, nblk, up_perm);
        if (more) tr_load(W, K, N, tb, lane, vb);
        __builtin_amdgcn_sched_barrier(0);
        tr_store((bf16_t*)(ws + WS_W + (size_t)ta.l * WL_STRIDE + woff), K, ta, scr, gl, lane, va);
        __builtin_amdgcn_sched_barrier(0);
        if (!more) break;
        it = nx; nx = it + ngw; more = nx < total;
        ta = tr_decode(more ? nx : it, per, nblk, up_perm);
        if (more) tr_load(W, K, N, ta, lane, va);
        __builtin_amdgcn_sched_barrier(0);
        tr_store((bf16_t*)(ws + WS_W + (size_t)tb.l * WL_STRIDE + woff), K, tb, scr, gl, lane, vb);
        __builtin_amdgcn_sched_barrier(0);
        if (!more) break;
        it = nx;
    }
}

__device__ __forceinline__ void s5_prep_item(const Ptrs& P, unsigned char* ws, int l, int g, float* lds, int tid) {
    float* Ktab = lds;
    float* apr = lds + 16384;
    float* api = apr + 2 * 33 * 64;
    float* bbr = api + 2 * 33 * 64;
    float* bbi = bbr + 2 * 64 * 16;
    float* ccr = bbi + 2 * 64 * 16;
    float* cci = ccr + 2 * 16 * 65;
    for (int idx = tid; idx < 2 * 16 * 64; idx += 512) { const int d = idx >> 10, i = (idx >> 6) & 15, p = idx & 63; const size_t o = (((size_t)(l * 2 + d) * SG + g) * SH + i) * SP + p;
        ccr[(d * 16 + i) * 65 + p] = P.s5_c_re()[o]; cci[(d * 16 + i) * 65 + p] = P.s5_c_im()[o]; }
    for (int idx = tid; idx < 2 * 33 * 64; idx += 512) {
        const int d = idx / (33 * 64), r = idx % (33 * 64), tau = r / 64, p = r % 64;
        const size_t o = ((size_t)(l * 2 + d) * SG + g) * SP + p;
        const float dt = __expf(P.s5_log_dt()[(l * 2 + d) * SG + g]);
        const float x = P.s5_a_re()[o] * dt * (float)tau, y = P.s5_a_im()[o] * dt * (float)tau;
        const float e = expf(x); float sn, cs; sincosf(y, &sn, &cs);
        apr[idx] = e * cs; api[idx] = e * sn;
    }
    for (int idx = tid; idx < 2 * 64 * 16; idx += 512) {
        const int d = idx / 1024, p = (idx % 1024) / 16, j = idx % 16;
        const size_t o = ((size_t)(l * 2 + d) * SG + g) * SP + p;
        const float dt = expf(P.s5_log_dt()[(l * 2 + d) * SG + g]);
        const float lr = P.s5_a_re()[o], li = P.s5_a_im()[o], x = lr * dt, y = li * dt;
        float sn, cs; sincosf(y, &sn, &cs); float sh, ch; sincosf(0.5f * y, &sh, &ch);
        const float nr = expm1f(x) * cs - 2.0f * sh * sh, ni = expf(x) * sn;
        const float den = 1.0f / (lr * lr + li * li);
        const float qr = (nr * lr + ni * li) * den, qi = (ni * lr - nr * li) * den;
        const float br = P.s5_b_re()[o * 16 + j], bi = P.s5_b_im()[o * 16 + j];
        bbr[idx] = qr * br - qi * bi; bbi[idx] = qr * bi + qi * br;
    }
    __syncthreads();
#pragma unroll 1
    for (int cb = tid; cb < 2 * 32 * 16; cb += 512) {
        const int d = cb >> 9, tau = (cb >> 4) & 31, i = cb & 15;
        const float* ar_ = apr + (d * 33 + tau) * 64; const float* ai_ = api + (d * 33 + tau) * 64; const float* cr_ = ccr + (d * 16 + i) * 65; const float* ci_ = cci + (d * 16 + i) * 65;
        f32x4 acc4[4] = {(f32x4){0.f, 0.f, 0.f, 0.f}, (f32x4){0.f, 0.f, 0.f, 0.f}, (f32x4){0.f, 0.f, 0.f, 0.f}, (f32x4){0.f, 0.f, 0.f, 0.f}};
#pragma unroll 4
        for (int p = 0; p < 64; ++p) {
            const float ar = ar_[p], ai = ai_[p], cr = cr_[p], ci = ci_[p];
            const float er = cr * ar - ci * ai, ei = cr * ai + ci * ar;
            const f32x4* br4 = (const f32x4*)(bbr + (d * 64 + p) * 16); const f32x4* bi4 = (const f32x4*)(bbi + (d * 64 + p) * 16);
#pragma unroll
            for (int v = 0; v < 4; ++v) acc4[v] = acc4[v] + br4[v] * er - bi4[v] * ei;
        }
        f32x4* o = (f32x4*)(Ktab + ((d * 32 + tau) * 16 + i) * 16);
#pragma unroll
        for (int v = 0; v < 4; ++v) o[v] = acc4[v];
    }
    __syncthreads();
    bf16_t* Bt2 = (bf16_t*)(ws + WS_S5 + (size_t)l * S5_STRIDE + S5_BT2) + (size_t)g * 512 * UHW;
    for (int pc = tid; pc < 512 * (UHW / 8); pc += 512) {
        const int n = pc / (UHW / 8), k8 = pc % (UHW / 8), t = n >> 4, i = n & 15;
        float v[8];
        if (k8 < 64) {
            const int s = k8 >> 1, j0 = (k8 & 1) * 8;
#pragma unroll
            for (int e = 0; e < 8; ++e) { const int j = j0 + e; float x;
                if (s < t) x = Ktab[(0 * 32 + (t - s)) * 256 + i * 16 + j];
                else if (s > t) x = Ktab[(1 * 32 + (s - t)) * 256 + i * 16 + j];
                else { x = Ktab[i * 16 + j] + Ktab[8192 + i * 16 + j]; if (i == j) x += P.s5_d()[(size_t)l * 1024 + g * 16 + i]; }
                v[e] = x; }
        } else {
            const int kk = (k8 - 64) * 8, sel = kk >> 6, p0 = kk & 63, d = sel >> 1, ex = d ? (32 - t) : (t + 1);
            const float* cr = ccr + (d * 16 + i) * 65; const float* ci = cci + (d * 16 + i) * 65;
#pragma unroll
            for (int e = 0; e < 8; ++e) { const int p = p0 + e; const float ar = apr[(d * 33 + ex) * 64 + p], ai = api[(d * 33 + ex) * 64 + p];
                const float wr_ = cr[p] * ar - ci[p] * ai, wi_ = cr[p] * ai + ci[p] * ar;
                v[e] = (sel & 1) ? -wi_ : wr_; }
        }
        u32x4 o; o.x = cvt_pk_bf16(v[0], v[1]); o.y = cvt_pk_bf16(v[2], v[3]); o.z = cvt_pk_bf16(v[4], v[5]); o.w = cvt_pk_bf16(v[6], v[7]);
        *(u32x4*)(Bt2 + (size_t)n * UHW + k8 * 8) = o;
    }
    bf16_t* Bt1 = (bf16_t*)(ws + WS_S5 + (size_t)l * S5_STRIDE + S5_BT1) + (size_t)g * 256 * 512;
    for (int pc = tid; pc < 256 * 64; pc += 512) {
        const int n = pc / 64, k8 = pc % 64, sel = n >> 6, p = n & 63, d = sel >> 1, s = k8 >> 1, j0 = (k8 & 1) * 8, ex = d ? s : (31 - s);
        const float ar = apr[(d * 33 + ex) * 64 + p], ai = api[(d * 33 + ex) * 64 + p];
        float v[8];
#pragma unroll
        for (int e = 0; e < 8; ++e) { const float br = bbr[(d * 64 + p) * 16 + j0 + e], bi = bbi[(d * 64 + p) * 16 + j0 + e];
            v[e] = (sel & 1) ? (ar * bi + ai * br) : (ar * br - ai * bi); }
        u32x4 o; o.x = cvt_pk_bf16(v[0], v[1]); o.y = cvt_pk_bf16(v[2], v[3]); o.z = cvt_pk_bf16(v[4], v[5]); o.w = cvt_pk_bf16(v[6], v[7]);
        *(u32x4*)(Bt1 + (size_t)n * 512 + k8 * 8) = o;
    }
    __syncthreads();
}

__device__ __forceinline__ void lru_prep(const Ptrs& P, unsigned char* ws, int gt, int ngt) {
    for (int idx = gt; idx < DEPTH * 2 * 1024; idx += ngt) { const float lam = P.lru_lambda()[idx]; ((float*)(ws + WS_C8V))[idx] = -8.0f * (lam > 15.f ? expf(-lam) : log1pf(expf(-lam))); }
    const int total = DEPTH * 16 * 8 * 4 * 64;
    for (int idx = gt; idx < total; idx += ngt) {
        const int lane = idx & 63, f = (idx >> 6) & 3, w = (idx >> 8) & 7, hb = (idx >> 11) & 15, l = idx >> 15;
        const int d = w >> 2, cs = w & 3, mat = f >> 1, ks = f & 1;
        const float* W = (mat ? P.lru_w_x() : P.lru_w_a()) + ((size_t)((l * 2 + d) * 16 + hb) * 64) * 64;
        float v[8];
#pragma unroll
        for (int e = 0; e < 8; ++e) v[e] = W[(size_t)(32 * ks + 8 * (lane >> 4) + e) * 64 + 16 * cs + (lane & 15)];
        u32x4 o; o.x = cvt_pk_bf16(v[0], v[1]); o.y = cvt_pk_bf16(v[2], v[3]); o.z = cvt_pk_bf16(v[4], v[5]); o.w = cvt_pk_bf16(v[6], v[7]);
        *(u32x4*)(ws + WS_LRUW + (size_t)idx * 16) = o;
    }
}

__device__ __forceinline__ void input_phase(const Ptrs& P, bf16_t* XB, u64* RS, int gw, int ngw, int lane) {
    for (int m = gw; m < T; m += ngw) {
        const float* src = m < 8192 ? P.x_prompt() + (size_t)m * D : P.x_sample() + (size_t)(m - 8192) * D;
        f32x4 v[8]; float s = 0.f;
#pragma unroll
        for (int j = 0; j < 4; ++j) { v[2 * j] = *(const f32x4*)(src + 8 * (lane + 64 * j)); v[2 * j + 1] = *(const f32x4*)(src + 8 * (lane + 64 * j) + 4); }
#pragma unroll
        for (int j = 0; j < 8; ++j) s += (v[j][0] * v[j][0] + v[j][1] * v[j][1]) + (v[j][2] * v[j][2] + v[j][3] * v[j][3]);
        s = wave_sum(s);
#pragma unroll
        for (int j = 0; j < 4; ++j) *(u32x4*)(XB + (size_t)m * D + 8 * (lane + 64 * j)) = pg8::pack8(v[2 * j], v[2 * j + 1]);
        if (lane == 0) RS[m] = (u64)(s * RSS_SCALE);
    }
}
__device__ __forceinline__ void fn_load(const bf16_t* XB, const u64* RS, int m, int lane, u32x4 (&x)[4], u64& r) {
    r = RS[m];
#pragma unroll
    for (int j = 0; j < 4; ++j) x[j] = *(const u32x4*)(XB + (size_t)m * D + 8 * (lane + 64 * j));
}
__device__ __forceinline__ void fn_store(float* OUT, int m, int lane, const u32x4 (&x)[4], u64 r, const f32x4 (&gv)[8]) {
    const float rstd = 1.0f / sqrtf(rss_mean(r) + EPS);
#pragma unroll
    for (int j = 0; j < 4; ++j) { f32x4 x0, x1; pg8::unpack8(x[j], x0, x1);
        float* o = OUT + (size_t)m * D + 8 * (lane + 64 * j); *(f32x4*)o = x0 * rstd * gv[2 * j]; *(f32x4*)(o + 4) = x1 * rstd * gv[2 * j + 1]; }
}
__device__ __forceinline__ void final_norm_phase(float* OUT, const bf16_t* XB, const u64* RS, const float* gain, int gw, int ngw, int lane) {
    f32x4 gv[8];
#pragma unroll
    for (int j = 0; j < 4; ++j) { gv[2 * j] = *(const f32x4*)(gain + 8 * (lane + 64 * j)); gv[2 * j + 1] = *(const f32x4*)(gain + 8 * (lane + 64 * j) + 4); }
    int m = gw;
    if (m >= T) return;
    u32x4 xa[4], xb[4]; u64 ra, rb = 0;
    fn_load(XB, RS, m, lane, xa, ra);
#pragma unroll 1
    while (true) {
        int mn = m + ngw; bool more = mn < T;
        if (more) fn_load(XB, RS, mn, lane, xb, rb);
        __builtin_amdgcn_sched_barrier(0);
        fn_store(OUT, m, lane, xa, ra, gv);
        __builtin_amdgcn_sched_barrier(0);
        if (!more) break;
        m = mn; mn = m + ngw; more = mn < T;
        if (more) fn_load(XB, RS, mn, lane, xa, ra);
        __builtin_amdgcn_sched_barrier(0);
        fn_store(OUT, m, lane, xb, rb, gv);
        __builtin_amdgcn_sched_barrier(0);
        if (!more) break;
        m = mn;
    }
}

__device__ __forceinline__ bool seq_start(int m) { return m == 0 || (m >= 8192 && (m & 4095) == 0); }
__device__ __forceinline__ int seq_lo(int m) { return m < 8192 ? 0 : (m & ~4095); }
__device__ __forceinline__ int seq_hi(int m) { return m < 8192 ? 8192 : (m & ~4095) + 4096; }

constexpr int XC_LD = 68, XCB_LD = 72;
__device__ __forceinline__ float expm1_over_x_small(float x) { float p = 1.0f / 720.0f; p = p * x + 1.0f / 120.0f; p = p * x + 1.0f / 24.0f; p = p * x + 1.0f / 6.0f; p = p * x + 0.5f; return p * x + 1.0f; }
__device__ __forceinline__ float exp_small(float x) { float p = 1.0f / 5040.0f; p = p * x + 1.0f / 720.0f; p = p * x + 1.0f / 120.0f; p = p * x + 1.0f / 24.0f; p = p * x + 1.0f / 6.0f; p = p * x + 0.5f; p = p * x + 1.0f; return p * x + 1.0f; }
__device__ __forceinline__ float neg_expm1_small(float x) { float p = 1.0f / 362880.0f; p = p * x + 1.0f / 40320.0f; p = p * x + 1.0f / 5040.0f; p = p * x + 1.0f / 720.0f; p = p * x + 1.0f / 120.0f; p = p * x + 1.0f / 24.0f; p = p * x + 1.0f / 6.0f; p = p * x + 0.5f; p = p * x + 1.0f; return -x * p; }
__device__ __forceinline__ float lru_xch16(float x, bool qodd) { const unsigned u = __float_as_uint(x); const auto r = __builtin_amdgcn_permlane16_swap(u, u, false, false); return __uint_as_float(qodd ? r[0] : r[1]); }
__device__ __forceinline__ float lru_xch32(float x, bool upper) { const unsigned u = __float_as_uint(x); const auto r = __builtin_amdgcn_permlane32_swap(u, u, false, false); return __uint_as_float(upper ? r[0] : r[1]); }
template <int PASS> __device__ __forceinline__ int lru_phase(const Ptrs& P, unsigned char* ws, int l, int hb, unsigned* ctr, unsigned char* lds, volatile LAS unsigned* MISC, int tid) {
    int nproc = 0;
    float* XC = (float*)lds;
    bf16_t* XCB = (bf16_t*)(lds + 128 * XC_LD * 4);
    float* HF = (float*)(lds + 128 * XC_LD * 4 + 128 * XCB_LD * 2);
    float* HB = HF + 128 * XC_LD;
    const bf16_t* XR = (const bf16_t*)(ws + WS_R + R_XR);
    const int ch0 = hb * 64, lane = tid & 63, wid = tid >> 6;
    const int c8 = (tid & 7) * 8, r0 = tid >> 3;
    u32x4 cwk[4]; f32x4 cbv[2];
    { const float* cwp = P.lru_conv_w() + (size_t)l * 4 * 1024 + ch0 + c8; const float* cbp = P.lru_conv_b() + (size_t)l * 1024 + ch0 + c8;
#pragma unroll
      for (int k = 0; k < 4; ++k) cwk[k] = pg8::pack8(*(const f32x4*)(cwp + k * 1024), *(const f32x4*)(cwp + k * 1024 + 4));
      cbv[0] = *(const f32x4*)cbp; cbv[1] = *(const f32x4*)(cbp + 4); }
    const int d = wid >> 2, cs = wid & 3, q = lane >> 4, chl = cs * 16 + (lane & 15), ch = ch0 + chl;
    const bf16x8* wf = (const bf16x8*)(ws + WS_LRUW + ((size_t)((l * 16 + hb) * 8 + wid) * 4) * 1024) + lane;
    const bf16x8 ba0 = wf[0], ba1 = wf[64], bx0 = wf[128], bx1 = wf[192];
    const float b_a = P.lru_b_a()[(size_t)(l * 2 + d) * 1024 + ch], b_x = P.lru_b_x()[(size_t)(l * 2 + d) * 1024 + ch];
    const float b_a2 = b_a * -1.44269504f, b_x2 = b_x * -1.44269504f;
    const float c8v = ((const float*)(ws + WS_C8V))[(size_t)(l * 2 + d) * 1024 + ch];
    const bool small = c8v > -0.35f;
    const int qq = d ? 3 - q : q;
    const bool hi1 = (qq & 1) != 0, hi2 = (qq & 2) != 0, qodd = (q & 1) != 0, upper = lane >= 32;
#define XCH16(x) lru_xch16((x), qodd)
#define XCH32(x) lru_xch32((x), upper)

    unsigned n2 = 0;
    if (tid == 0) { const unsigned c0 = xb_add(ctr, 1u), c1 = xb_add(ctr, 1u); MISC[16] = c0; MISC[17] = c1; }
    __syncthreads();
    unsigned cur = MISC[16], nx1 = MISC[17];
    __syncthreads();
    u32x4 xpf[2][4];
    const unsigned rowoff = (unsigned)(r0 * 1024 + ch0 + c8) * 2u;
#define LRU_PREFETCH(tcx) do { const int t0p = (int)(tcx) * LT, lop = seq_lo(t0p), hip = seq_hi(t0p); \
        _Pragma("unroll") for (int it = 0; it < 2; ++it) _Pragma("unroll") for (int k = 0; k < 4; ++k) { const int ts = t0p + r0 + it * 64 + k - 2; \
            xpf[it][k] = (ts >= lop && ts < hip) ? *(const u32x4*)((const char*)XR + (rowoff + (unsigned)((t0p + it * 64 + k - 2) * 2048))) : (u32x4){0u, 0u, 0u, 0u}; } } while (0)
    if (cur < (unsigned)NTC) LRU_PREFETCH(cur);
    const bf16_t* GG = (const bf16_t*)(ws + WS_R + R_GG); bf16_t* YB = (bf16_t*)(ws + WS_R + R_YB);
    while (cur < (unsigned)NTC) {
        if (tid == 0) n2 = xb_add(ctr, 1u);
        const int tc = (int)cur, t0 = tc * LT;
        u32x4 ggv[2]; float carry = 0.f;
        if (PASS == 2) {
#pragma unroll
            for (int it = 0; it < 2; ++it) ggv[it] = *(const u32x4*)((const char*)GG + (rowoff + (unsigned)((t0 + it * 64) * 2048)));
            carry = *(const float*)((const char*)(ws + WS_R + R_CIN) + (unsigned)(((d * NTC + tc) * 1024 + ch) * 4));
        }
#pragma unroll
        for (int it = 0; it < 2; ++it) {
            const int r = r0 + it * 64;
            f32x4 a0 = cbv[0], a1 = cbv[1];
#pragma unroll
            for (int k = 0; k < 4; ++k) { f32x4 x0, x1, w0, w1; pg8::unpack8(xpf[it][k], x0, x1); pg8::unpack8(cwk[k], w0, w1); a0 = a0 + w0 * x0; a1 = a1 + w1 * x1; }
            *(f32x4*)(XC + r * XC_LD + c8) = a0; *(f32x4*)(XC + r * XC_LD + c8 + 4) = a1;
            *(u32x4*)(XCB + r * XCB_LD + c8) = pg8::pack8(a0, a1);
        }
        if (nx1 < (unsigned)NTC) LRU_PREFETCH(nx1);
        __syncthreads();
        f32x4 gr_[8], gg_[8];
#pragma unroll
        for (int mt = 0; mt < 8; ++mt) {
            const bf16x8 fa0 = *(const bf16x8*)(XCB + (mt * 16 + (lane & 15)) * XCB_LD + 8 * q), fa1 = *(const bf16x8*)(XCB + (mt * 16 + (lane & 15)) * XCB_LD + 32 + 8 * q);
            const f32x4 z = (f32x4){0.f, 0.f, 0.f, 0.f};
            gr_[mt] = __builtin_amdgcn_mfma_f32_16x16x32_bf16(fa0, ba0, z, 0, 0, 0); gr_[mt] = __builtin_amdgcn_mfma_f32_16x16x32_bf16(fa1, ba1, gr_[mt], 0, 0, 0);
            gg_[mt] = __builtin_amdgcn_mfma_f32_16x16x32_bf16(fa0, bx0, z, 0, 0, 0); gg_[mt] = __builtin_amdgcn_mfma_f32_16x16x32_bf16(fa1, bx1, gg_[mt], 0, 0, 0);
        }
        float totA = 1.0f, totB = 0.0f;
        float* Hout = d ? HB : HF;
#define LRU_TILE(mt, R0, R1, R2, R3) do { constexpr bool FASTP_ = false; \
            f32x4 ar = gr_[mt], ag = gg_[mt]; \
              \
            f32x4 xcv4; _Pragma("unroll") for (int rg = 0; rg < 4; ++rg) xcv4[rg] = XC[((mt) * 16 + 4 * q + rg) * XC_LD + chl]; \
            f32x4 tr = ar * -1.44269504f + b_a2, tg = ag * -1.44269504f + b_x2;            \
            _Pragma("unroll") for (int rg = 0; rg < 4; ++rg) { tr[rg] = __builtin_amdgcn_exp2f(tr[rg]); tg[rg] = __builtin_amdgcn_exp2f(tg[rg]); } \
            tr = tr + 1.0f; tg = tg + 1.0f; \
            _Pragma("unroll") for (int rg = 0; rg < 4; ++rg) { tr[rg] = __builtin_amdgcn_rcpf(tr[rg]); tg[rg] = __builtin_amdgcn_rcpf(tg[rg]); } \
            const f32x4 la4 = tr * c8v; \
            if (FASTP_ || small) { f32x4 p = la4 * (1.0f / 720.0f) + (1.0f / 120.0f); p = p * la4 + (1.0f / 24.0f); p = p * la4 + (1.0f / 6.0f); p = p * la4 + 0.5f; p = p * la4 + 1.0f; \
                const f32x4 am1 = la4 * p; ar = am1 + 1.0f; ag = -am1 * (am1 + 2.0f); }            \
            else { _Pragma("unroll") for (int rg = 0; rg < 4; ++rg) { ar[rg] = __expf(la4[rg]); ag[rg] = -expm1f(2.0f * la4[rg]); } } \
            _Pragma("unroll") for (int rg = 0; rg < 4; ++rg) ag[rg] = __builtin_amdgcn_sqrtf(ag[rg]); \
            ag = ag * tg * xcv4; \
            float A = ar[R0], B = ag[R0]; \
            B = B * ar[R1] + ag[R1]; A *= ar[R1]; B = B * ar[R2] + ag[R2]; A *= ar[R2]; B = B * ar[R3] + ag[R3]; A *= ar[R3]; \
              \
            const float Ap = XCH16(A), Bp = XCH16(B); \
            const float pairA = A * Ap, pairB = hi1 ? Bp * A + B : B * Ap + Bp;         \
            const float Ae1 = hi1 ? Ap : 1.0f, Be1 = hi1 ? Bp : 0.0f;                   \
            const float PAp = XCH32(pairA), PBp = XCH32(pairB); \
            const float At = pairA * PAp, Bt = hi2 ? PBp * pairA + pairB : pairB * PAp + PBp;     \
            if (PASS == 1) { totB = totB * At + Bt; totA *= At; } \
            else { \
                const float Ae = hi2 ? PAp * Ae1 : Ae1, Be = hi2 ? PBp * Ae1 + Be1 : Be1;     \
                float h = Ae * carry + Be;                                              \
                h = ar[R0] * h + ag[R0]; Hout[((mt) * 16 + 4 * q + R0) * XC_LD + chl] = h; \
                h = ar[R1] * h + ag[R1]; Hout[((mt) * 16 + 4 * q + R1) * XC_LD + chl] = h; \
                h = ar[R2] * h + ag[R2]; Hout[((mt) * 16 + 4 * q + R2) * XC_LD + chl] = h; \
                h = ar[R3] * h + ag[R3]; Hout[((mt) * 16 + 4 * q + R3) * XC_LD + chl] = h; \
                carry = At * carry + Bt; } \
        } while (0)
        if (d == 0) {
#pragma unroll
            for (int mt = 0; mt < 8; ++mt) LRU_TILE(mt, 0, 1, 2, 3);
        } else {
#pragma unroll
            for (int mt = 7; mt >= 0; --mt) LRU_TILE(mt, 3, 2, 1, 0);
        }
#undef LRU_TILE
#undef XCH16
#undef XCH32
        if (PASS == 1) {
            if (q == 0) *(f32x2*)((char*)(ws + WS_R + R_LSUM) + (unsigned)(((d * NTC + tc) * 1024 + ch) * 8)) = (f32x2){totA, totB};
        } else {
            __syncthreads();
#pragma unroll
            for (int it = 0; it < 2; ++it) {
                const int r = r0 + it * 64;
                f32x4 g0, g1; pg8::unpack8(ggv[it], g0, g1);
                const f32x4 y0 = (*(const f32x4*)(HF + r * XC_LD + c8) + *(const f32x4*)(HB + r * XC_LD + c8)) * g0, y1 = (*(const f32x4*)(HF + r * XC_LD + c8 + 4) + *(const f32x4*)(HB + r * XC_LD + c8 + 4)) * g1;
                *(u32x4*)((char*)YB + (rowoff + (unsigned)((t0 + it * 64) * 2048))) = pg8::pack8(y0, y1);
            }
        }
        if (tid == 0) MISC[16] = n2;
        __syncthreads();
        cur = nx1; nx1 = MISC[16]; ++nproc;
    }
#undef LRU_PREFETCH
    return nproc;
}

__device__ __forceinline__ void s5_chain(const Ptrs& P, unsigned char* ws, int l, int g, int d, int p, int c_lo, int n) {
    const size_t o = ((size_t)(l * 2 + d) * SG + g) * SP + p;
    const float dt = expf(P.s5_log_dt()[(l * 2 + d) * SG + g]);
    const float x = P.s5_a_re()[o] * dt * 32.0f, y = P.s5_a_im()[o] * dt * 32.0f;
    const float e = expf(x); float sn, cs; sincosf(y, &sn, &cs);
    const float ar = e * cs, ai = e * sn;
    const float* Sb = (const float*)(ws + WS_R + R_SBUF) + (size_t)g * NCR * 256 + d * 128 + p;
    bf16_t* Hb = (bf16_t*)(ws + WS_R + R_UH) + (size_t)g * NCR * UHW + 512 + d * 128 + p;
    float hr = 0.f, hi = 0.f;
    for (int c0 = 0; c0 < n; c0 += 8) {
        float sr[8], si[8];
#pragma unroll
        for (int j = 0; j < 8; ++j) { const int cr = d ? c_lo + n - 1 - (c0 + j) : c_lo + c0 + j; sr[j] = Sb[(size_t)cr * 256]; si[j] = Sb[(size_t)cr * 256 + 64]; }
#pragma unroll
        for (int j = 0; j < 8; ++j) { const int cr = d ? c_lo + n - 1 - (c0 + j) : c_lo + c0 + j;
            Hb[(size_t)cr * UHW] = (bf16_t)(cvt_pk_bf16(hr, 0.f) & 0xffffu); Hb[(size_t)cr * UHW + 64] = (bf16_t)(cvt_pk_bf16(hi, 0.f) & 0xffffu);
            const float nr = ar * hr - ai * hi + sr[j], ni = ar * hi + ai * hr + si[j]; hr = nr; hi = ni; }
    }
}
__device__ __forceinline__ void lru_chain(unsigned char* ws, int ch, int d, int sq) {
    const int c_lo = sq == 0 ? 0 : 64 + 32 * (sq - 1), n = sq == 0 ? 64 : 32;
    const float* Ls = (const float*)(ws + WS_R + R_LSUM) + ((size_t)d * NTC * 1024 + ch) * 2;
    float* Ci = (float*)(ws + WS_R + R_CIN) + (size_t)d * NTC * 1024 + ch;
    float carry = 0.f;
    for (int c0 = 0; c0 < n; c0 += 8) {
        f32x2 ab[8];
#pragma unroll
        for (int j = 0; j < 8; ++j) { const int tc = d ? c_lo + n - 1 - (c0 + j) : c_lo + c0 + j; ab[j] = *(const f32x2*)(Ls + (size_t)tc * 2048); }
#pragma unroll
        for (int j = 0; j < 8; ++j) { const int tc = d ? c_lo + n - 1 - (c0 + j) : c_lo + c0 + j; Ci[(size_t)tc * 1024] = carry; carry = ab[j][0] * carry + ab[j][1]; }
    }
}
__device__ __forceinline__ bool count_in_last(unsigned* cnt, unsigned add, unsigned target, volatile LAS unsigned* MISC, int tid) {
    asm volatile("s_waitcnt vmcnt(0)" ::: "memory");
    __syncthreads();
    if (tid == 0) {
        __builtin_amdgcn_fence(__ATOMIC_RELEASE, "agent");
        asm volatile("s_waitcnt vmcnt(0)" ::: "memory");
        const unsigned old = xb_add(cnt, add);
        const unsigned last = (old + add == target) ? 1u : 0u;
        if (last) { __builtin_amdgcn_fence(__ATOMIC_ACQUIRE, "agent"); asm volatile("s_waitcnt vmcnt(0)" ::: "memory"); }
        MISC[20] = last;
    }
    __syncthreads();
    const bool r = MISC[20] != 0u;
    __syncthreads();
    return r;
}

__device__ __forceinline__ void fix_rows_of_panel(const Ptrs& P, unsigned char* ws, int l, int pm, int tid) {
    const float* EDGE = (const float*)(ws + WS_R + R_EDGE); bf16_t* ACT = (bf16_t*)(ws + WS_R + R_ACT); const float* cw = P.ffn_conv_w() + (size_t)l * 3 * F2;
    for (int idx = tid; idx < 2 * (FH / 4); idx += 512) {
        const int c4 = (idx % (FH / 4)) * 4, which = idx / (FH / 4);
        const int b = pm + which; if (b < 1 || b > 95 || seq_start(b * 256)) continue;
        const float* e0 = which ? EDGE + ((size_t)pm * 4 + 2) * 2 * FH : EDGE + ((size_t)(pm - 1) * 4 + 3) * 2 * FH;
        const float* e1 = which ? EDGE + ((size_t)pm * 4 + 3) * 2 * FH : EDGE + ((size_t)pm * 4 + 0) * 2 * FH;
        const float* e2 = which ? EDGE + ((size_t)(pm + 1) * 4 + 0) * 2 * FH : EDGE + ((size_t)pm * 4 + 1) * 2 * FH;
        const f32x4 pg = *(const f32x4*)(e0 + c4), cg = *(const f32x4*)(e1 + c4), ng = *(const f32x4*)(e2 + c4);
        const f32x4 hg = *(const f32x4*)(cw + c4) * pg + *(const f32x4*)(cw + F2 + c4) * cg + *(const f32x4*)(cw + 2 * F2 + c4) * ng;
        const f32x4 pv = *(const f32x4*)(e0 + FH + c4), cv = *(const f32x4*)(e1 + FH + c4), nv = *(const f32x4*)(e2 + FH + c4);
        const f32x4 hv = *(const f32x4*)(cw + FH + c4) * pv + *(const f32x4*)(cw + F2 + FH + c4) * cv + *(const f32x4*)(cw + 2 * F2 + FH + c4) * nv;
        u32x2 o; o.x = cvt_pk_bf16(gelu_tanh(hg[0]) * hv[0], gelu_tanh(hg[1]) * hv[1]); o.y = cvt_pk_bf16(gelu_tanh(hg[2]) * hv[2], gelu_tanh(hg[3]) * hv[3]);
        *(u32x2*)(ACT + (size_t)(pm * 256 + which * 255) * FH + c4) = o;
    }
}

__global__ void __launch_bounds__(512, 2) fwd(Args args) {
    extern __shared__ __attribute__((aligned(16))) unsigned char lds[];
    const int wave_s = __builtin_amdgcn_readfirstlane((int)threadIdx.x >> 6);
    const int G = gridDim.x, bx = blockIdx.x;
#define WAVE_OF(td) __builtin_amdgcn_readfirstlane((td) >> 6)
    LAS unsigned char* ldsl = (LAS unsigned char*)lds;
    volatile LAS unsigned* MISC = (volatile LAS unsigned*)(ldsl + MISC_OFF);
    { const int t0_ = tid_of(wave_s); if (t0_ < 64) MISC[t0_] = 0u; }
    __syncthreads();
    const int lo = args.ph_lo, hi = args.ph_hi;
    XcdBarrier bar; bar.bar = (unsigned*)(args.ws + WS_CTL) + CW_BAR; bar.x = 0; bar.st = MISC + 8;
    if (hi - lo > 1) bar = xcd_barrier_post((unsigned*)(args.ws + WS_CTL) + CW_BAR, MISC + 8);
#ifndef PH_MASK
#define PH_MASK 0xFFFF
#endif
#define EN(k) (((PH_MASK) >> (k)) & 1)
#ifndef PROBE_REP
#define PROBE_REP -1
#endif
#define NREP(k) (((k) == (PROBE_REP)) ? 2 : 1)
#define RUN(p) (lo <= (p) && (p) < hi)
#ifdef PROBE_TIME
    long long tph = wall_clock64();
#ifdef PROBE_SKEW
#define PROBE_SKEW_SPIN(p) do { if (bx == 0 && (p) == (PROBE_TIME)) { unsigned* cw_ = (unsigned*)(args.ws + WS_CTL) + 20000; const unsigned mn = 0xFFFFFFFFu - __hip_atomic_load(cw_, __ATOMIC_RELAXED, __HIP_MEMORY_SCOPE_AGENT), mx = __hip_atomic_load(cw_ + 64, __ATOMIC_RELAXED, __HIP_MEMORY_SCOPE_AGENT); \
        const long long until = wall_clock64() + (long long)(mx - mn) * 4; while (wall_clock64() < until) __builtin_amdgcn_s_sleep(8); } } while (0)
#else
#define PROBE_SKEW_SPIN(p) do { } while (0)
#endif
#ifdef PROBE_SKEW
#define SKEW_RECORD(p) do { if ((p) == (PROBE_TIME) && tid_of(wave_s) == 0) { const unsigned el = (unsigned)(wall_clock64() - tph); unsigned* cw_ = (unsigned*)(args.ws + WS_CTL) + 20000; \
        atomicMax(cw_, 0xFFFFFFFFu - el); atomicMax(cw_ + 64, el); } } while (0)
#else
#define SKEW_RECORD(p) do { } while (0)
#endif
#ifndef PROBE_TIME_FULL
#define PROBE_TIME_FULL 0
#endif
#define SEAM(p) do { if (RUN(p) && RUN((p) + 1)) { SKEW_RECORD(p); if (!PROBE_TIME_FULL && bx == 0 && (p) == (PROBE_TIME)) { const long long w1 = wall_clock64(), until = w1 + (w1 - tph) * 4; while (wall_clock64() < until) __builtin_amdgcn_s_sleep(8); } \
        xcd_barrier(bar); \
        PROBE_SKEW_SPIN(p); \
        if (PROBE_TIME_FULL == 1 && bx == 0 && (p) == (PROBE_TIME)) { const long long w1 = wall_clock64(), until = w1 + (w1 - tph) * 4; while (wall_clock64() < until) __builtin_amdgcn_s_sleep(8); } \
        tph = wall_clock64(); } } while (0)
#else
#ifdef PROBE_DOUBLE_BAR
#define SEAM(p) do { if (RUN(p) && RUN((p) + 1)) { xcd_barrier(bar); xcd_barrier(bar); } } while (0)
#else
#define SEAM(p) do { if (RUN(p) && RUN((p) + 1)) xcd_barrier(bar); } while (0)
#endif
#endif

#define XN   ((bf16_t*)(w + WS_XN))
#define UH   ((bf16_t*)(w + WS_R + R_UH))
#define XR   ((bf16_t*)(w + WS_R + R_XR))
#define TMP  ((bf16_t*)(w + WS_R + R_TMP))
#define GG   ((bf16_t*)(w + WS_R + R_GG))
#define SGA  ((bf16_t*)(w + WS_R + R_SGA))
#define SGB  ((bf16_t*)(w + WS_R + R_SGB))
#define SBUF ((float*)(w + WS_R + R_SBUF))
#define YA   ((bf16_t*)(w + WS_R + R_YA))
#define YG   ((bf16_t*)(w + WS_R + R_YG))
#define YB   ((bf16_t*)(w + WS_R + R_YB))
#define ACT  ((bf16_t*)(w + WS_R + R_ACT))
#define EDGE ((float*)(w + WS_R + R_EDGE))
#define RSS  ((u64*)(w + WS_RSS))
#define LRUQ ((unsigned*)(w + WS_CTL) + CW_LRUQ)
#define PHASE_LOCALS unsigned z_ = 0u; asm volatile("" : "+s"(z_)); Ptrs Q; Q.a = (const __attribute__((address_space(4))) Args*)((const __attribute__((address_space(4))) char*)__builtin_amdgcn_kernarg_segment_ptr() + z_); \
    unsigned char* w = (unsigned char*)(GAS unsigned char*)Q.a->ws; float* Xl = (float*)(GAS float*)Q.a->out; (void)w; (void)Xl; \
    int bxl = bx, Gl = G; asm volatile("" : "+s"(bxl), "+s"(Gl)); const int ngwl = Gl * 8, ngtl = Gl * 512; (void)ngwl; (void)ngtl
    for (int rep = 0; rep < NREP(0); ++rep) if (EN(0) && RUN(0)) { PHASE_LOCALS;
        const int td = tid_of(wave_s), lane = td & 63, wave = WAVE_OF(td), gw = bxl * 8 + wave, gt = bxl * 512 + td;
#ifndef PROBE_PRO
#define PROBE_PRO 0
#endif
#ifdef PROBE_PRO_T
        long long tp0 = wall_clock64(), tp1, tp2, tp3;
#endif
        for (int r3 = 0; r3 < (PROBE_PRO == 3 ? 2 : 1); ++r3) input_phase(Q, XN, RSS, gw, ngwl, lane);
#ifdef PROBE_PRO_T
        tp1 = wall_clock64();
#endif
#pragma unroll 1
        for (int pass = 0; pass < 2; ++pass) {
            if ((pass == 0) == ((bxl & 1) == 0)) {
                for (int it = bxl; it < DEPTH * SG; it += Gl) s5_prep_item(Q, w, it / SG, it % SG, (float*)lds, td);
            } else {
                lru_prep(Q, w, gt, ngtl);
                float* scr = (float*)(lds + wave * 8448); float* glds = (float*)(lds + 73728);
                transpose_all(Q.w_in(), D, INC, w, WL_IN, false, Q.norm1_g(), scr, glds, td, lane, gw, ngwl);
                transpose_all(Q.s5_w_glu(), 1024, 1024, w, WL_GLU, false, nullptr, scr, glds, td, lane, gw, ngwl);
                transpose_all(Q.w_proj_a(), 1024, D, w, WL_PA, false, nullptr, scr, glds, td, lane, gw, ngwl);
                transpose_all(Q.w_proj_b(), 1024, D, w, WL_PB, false, nullptr, scr, glds, td, lane, gw, ngwl);
                transpose_all(Q.w_out(), D, D, w, WL_OUT, false, nullptr, scr, glds, td, lane, gw, ngwl);
                transpose_all(Q.ffn_w_up(), D, F2, w, WL_UP, true, Q.norm2_g(), scr, glds, td, lane, gw, ngwl);
                transpose_all(Q.ffn_w_down(), FH, D, w, WL_DOWN, false, nullptr, scr, glds, td, lane, gw, ngwl);
            }
            __syncthreads();
        }
#ifdef PROBE_PRO_T
        tp3 = wall_clock64();
        if (bxl == 0) { const long long dt_ = (PROBE_PRO_T == 1) ? tp1 - tp0 : (PROBE_PRO_T == 2) ? tp2 - tp1 : tp3 - tp2; const long long until = wall_clock64() + dt_ * 4; while (wall_clock64() < until) __builtin_amdgcn_s_sleep(8); }
#endif
        __syncthreads();
    }
    SEAM(0);

#pragma unroll 1
    for (int l = 0; l < DEPTH; ++l) {
        const int pb = 1 + l * NPH_LAYER;
#define wl (w + WS_W + (size_t)l * WL_STRIDE)
        for (int rep = 0; rep < NREP(1); ++rep) if (EN(1) && RUN(pb + 0)) { PHASE_LOCALS;
            pg8::Gemm g{XN, (const bf16_t*)(wl + WL_IN), D, D, D}; pg8::OrderMN S; S.init(T, INC, Gl, bxl); if (Gl == 256) S.iend = IN_FULL_ROUNDS;
#ifdef PROBE_HALFK
            if (rep == 0) g.K = D / 2;
#endif
            pg8::EpiIn E{UH, XR, GG, SGA, SGB, RSS + (size_t)(2 * l) * T, ldsl + SIDE_OFF};
#ifdef PROBE_STAGGER
            if (bxl & 1) { const long long until = wall_clock64() + (PROBE_STAGGER) * 100; while (wall_clock64() < until) __builtin_amdgcn_s_sleep(8); }
#endif
#ifdef PROBE_CLOCK
            long long c0 = clock64(), w0 = wall_clock64();
#endif
            pg8::gemm_phase(ldsl, g, S, E, wave_s);
#ifdef PROBE_CLOCK
            if (l == 1 && bxl == 0) { const long long c1 = clock64(), w1 = wall_clock64(); const long long ratio16 = (c1 - c0) * 16 / (w1 - w0);
              const long long until = w1 + ratio16 * 100; while (wall_clock64() < until) __builtin_amdgcn_s_sleep(8); }
#endif
        }
        SEAM(pb + 0);
        for (int rep = 0; rep < NREP(2); ++rep) if (EN(2) && RUN(pb + 1)) { PHASE_LOCALS;
            if (Gl == 256) { pg8::Gemm g{XN, (const bf16_t*)(wl + WL_IN), D, D, D}; pg8::OrderMN S; S.init(T, INC, Gl, bxl); S.i0 = IN_FULL_ROUNDS;
              pg8::EpiIn E{UH, XR, GG, SGA, SGB, RSS + (size_t)(2 * l) * T, ldsl + SIDE_OFF}; pg8::gemm_phase(ldsl, g, S, E, wave_s); }
            { pg8::Gemm g{UH, (const bf16_t*)(w + WS_S5 + (size_t)l * S5_STRIDE + S5_BT1), UHW, 512, 512}; pg8::OrderBatched<3, 1, NCR, 256, SG> S; S.init(Gl, (bxl + Gl - Gl / 4) % Gl);
              pg8::EpiS1 E{SBUF}; pg8::gemm_phase(ldsl, g, S, E, wave_s);
              const int td = tid_of(wave_s); pg8::Unit uu;
#pragma unroll 1
              for (int i = 0; S.next(i, uu); ++i)
                  if (count_in_last((unsigned*)(w + WS_CTL) + CW_SCNT + (l * SG + uu.g) * 16, 1u, 3u, MISC, td))
                      for (int t = td; t < 5 * 2 * SP; t += 512) { const int p = t & 63, d = (t >> 6) & 1, sq = t >> 7; s5_chain(Q, w, l, uu.g, d, p, sq == 0 ? 0 : 256 + 128 * (sq - 1), sq == 0 ? 256 : 128); } }
            { const int td = tid_of(wave_s), hb = bxl & 15;
              const int nproc = lru_phase<1>(Q, w, l, hb, LRUQ + ((l * 2 + 0) * 16 + hb) * 16 + rep * 8, lds, MISC, td);
              if (count_in_last((unsigned*)(w + WS_CTL) + CW_LCNT + (l * 16 + hb) * 16, (unsigned)nproc, (unsigned)NTC, MISC, td))
                  for (int t = td; t < 5 * 2 * 64; t += 512) lru_chain(w, hb * 64 + (t & 63), (t >> 6) & 1, t >> 7); }
        }
        SEAM(pb + 1);
        for (int rep = 0; rep < NREP(4); ++rep) if (EN(4) && RUN(pb + 2)) { PHASE_LOCALS;
            { pg8::Gemm g{UH, (const bf16_t*)(w + WS_S5 + (size_t)l * S5_STRIDE + S5_BT2), UHW, UHW, UHW}; pg8::OrderBatched<3, 2, NCR, 512, SG> S; S.init(Gl, bxl);
              pg8::EpiS2 E{YG}; pg8::gemm_phase(ldsl, g, S, E, wave_s); }
            lru_phase<2>(Q, w, l, bxl & 15, LRUQ + ((l * 2 + 1) * 16 + (bxl & 15)) * 16 + rep * 8, lds, MISC, tid_of(wave_s));
        }
        SEAM(pb + 2);
        for (int rep = 0; rep < NREP(5); ++rep) if (EN(5) && RUN(pb + 3)) { PHASE_LOCALS;
            { pg8::Gemm g{YG, (const bf16_t*)(wl + WL_GLU), 1024, 1024, 1024}; pg8::OrderMN S; S.init(T, 1024, Gl, bxl); pg8::EpiMul<0> E{YA, YG, 1024}; pg8::gemm_phase(ldsl, g, S, E, wave_s); }
            { pg8::Gemm g{YB, (const bf16_t*)(wl + WL_PB), 1024, 1024, 1024}; pg8::OrderMN S; S.init(T, D, Gl, bxl); pg8::EpiMul<1> E{TMP, SGB, D}; pg8::gemm_phase(ldsl, g, S, E, wave_s); }
        }
        SEAM(pb + 3);
        if (EN(6) && RUN(pb + 4)) { PHASE_LOCALS; pg8::Gemm g{YA, (const bf16_t*)(wl + WL_PA), 1024, 1024, 1024}; pg8::OrderMN S; S.init(T, D, Gl, bxl); pg8::EpiMul<2> E{TMP, SGA, D}; pg8::gemm_phase(ldsl, g, S, E, wave_s); }
        SEAM(pb + 4);
        if (EN(7) && RUN(pb + 5)) { PHASE_LOCALS; pg8::Gemm g{TMP, (const bf16_t*)(wl + WL_OUT), D, D, D}; pg8::OrderMN S; S.init(T, D, Gl, bxl); pg8::EpiRes E{XN, RSS + (size_t)(2 * l + 1) * T}; pg8::gemm_phase(ldsl, g, S, E, wave_s); }
        SEAM(pb + 5);
        for (int rep = 0; rep < NREP(8); ++rep) if (EN(8) && RUN(pb + 6)) { PHASE_LOCALS;
            pg8::Gemm g{XN, (const bf16_t*)(wl + WL_UP), D, D, D}; pg8::OrderMN S; S.init(T, F2, Gl, bxl);
#ifdef PROBE_HALFK_UP
            if (rep == 0) g.K = D / 2;
#endif
            pg8::EpiUp E{ACT, EDGE, Q.ffn_conv_w() + (size_t)l * 3 * F2, RSS + (size_t)(2 * l + 1) * T, ldsl + SIDE_OFF, (LAS float*)(ldsl + XCH_OFF)};
            pg8::gemm_phase(ldsl, g, S, E, wave_s);
        }
        SEAM(pb + 6);
        if (EN(10) && RUN(pb + 7)) { PHASE_LOCALS; pg8::Gemm g{ACT, (const bf16_t*)(wl + WL_DOWN), FH, FH, FH}; pg8::OrderMN S; S.init(T, D, Gl, bxl); pg8::EpiRes E{XN, RSS + (size_t)(2 * l + 2) * T};
            { const int td = tid_of(wave_s); pg8::Unit uu; int lastpm = -1;
#pragma unroll
              for (int i = 0; i < 4; ++i) { const bool ok = S.next(i, uu); const int pmv = ok ? uu.pm : lastpm; if (pmv != lastpm) { fix_rows_of_panel(Q, w, l, pmv, td); lastpm = pmv; } }
              asm volatile("s_waitcnt vmcnt(0)" ::: "memory"); __syncthreads(); }
            pg8::gemm_phase(ldsl, g, S, E, wave_s); }
        SEAM(pb + 7);
    }
    if (EN(11) && RUN(NPHASE - 1)) { PHASE_LOCALS; const int td = tid_of(wave_s); final_norm_phase(Xl, XN, RSS + (size_t)8 * T, Q.final_g(), bxl * 8 + WAVE_OF(td), ngwl, td & 63); }
#ifdef PROBE_TIME
    if (bx == 0 && (PROBE_TIME) == NPHASE - 1) { const long long w1 = wall_clock64(), until = w1 + (w1 - tph) * 4; while (wall_clock64() < until) __builtin_amdgcn_s_sleep(8); }
#endif
#undef RUN
#undef SEAM
}

extern "C" void kernel_launch(void* const* d_in, const int* in_sizes, int n_in, void* d_out, int out_size, void* d_ws, size_t ws_size, hipStream_t stream) {
    static int grid = 0;
    if (grid == 0) {
        if (n_in != 28 || out_size != T * D || ws_size < WS_END) { fprintf(stderr, "kernel_launch: unexpected shapes: n_in %d out %d ws %zu (need %zu)\n", n_in, out_size, ws_size, (size_t)WS_END); grid = -1; return; }
        int dev = 0, cus = 0, per_cu = 0;
        if (hipGetDevice(&dev) != hipSuccess || hipDeviceGetAttribute(&cus, hipDeviceAttributeMultiprocessorCount, dev) != hipSuccess) { grid = -1; return; }
        if (hipFuncSetAttribute((const void*)fwd, hipFuncAttributeMaxDynamicSharedMemorySize, LDS_BYTES) != hipSuccess) { fprintf(stderr, "kernel_launch: hipFuncSetAttribute failed\n"); grid = -1; return; }
        if (hipOccupancyMaxActiveBlocksPerMultiprocessor(&per_cu, (const void*)fwd, 512, LDS_BYTES) != hipSuccess || per_cu < 1) { fprintf(stderr, "kernel_launch: occupancy query says %d\n", per_cu); }
        (void)hipGetLastError();
        grid = cus;
    }
    if (grid < 0) return;
    (void)hipMemsetAsync((char*)d_ws + WS_CTL, 0, CTL_BYTES, stream);
    Args a{};
    for (int i = 0; i < 28; ++i) a.in[i] = (const float*)d_in[i];
    a.out = (float*)d_out; a.ws = (unsigned char*)d_ws;
#if MK_ONE_LAUNCH
    a.ph_lo = 0; a.ph_hi = NPHASE;
    hipLaunchKernelGGL(fwd, dim3(grid), dim3(512), LDS_BYTES, stream, a);
#else
    for (int p = 0; p < NPHASE; ++p) { a.ph_lo = p; a.ph_hi = p + 1; hipLaunchKernelGGL(fwd, dim3(grid), dim3(512), LDS_BYTES, stream, a); }
#endif
}
```
